# Optimizing an MI355X kernel written in HIP

```python
import jax, jax.numpy as jnp
from jax import lax

D_MODEL = 4096
BATCH = 1
SEQ = 8192
DEPTH = 1

HEAD_DIM = 128
ROPE_THETA = 10000.0
NORM_EPS = 1e-6
NEG_INF = -1e30
QBLK = 128

DIL_WINDOWS = (128, 512, 2048)
DIL_RATES = (1, 4, 16)
N_DIL = 3
DIL_HEADS = 4
DIL_NKEYS = DIL_WINDOWS[0] // DIL_RATES[0] + 1
A_HEADS = N_DIL * DIL_HEADS
A_W = A_HEADS * HEAD_DIM
A_OUT_W = DIL_HEADS * HEAD_DIM

NSA_HEADS = 16
NSA_KV = 4
NSA_QPG = NSA_HEADS // NSA_KV
B_W = NSA_HEADS * HEAD_DIM
KV_W = NSA_KV * HEAD_DIM
CMP_LEN = 32
CMP_STRIDE = 16
CMP_HID = HEAD_DIM
SEL_LEN = 64
SEL_TOP = 16
WIN = 512
FORCE_BONUS = 1000.0
N_NSA_GATES = 3

D_FF = -(-8 * D_MODEL // (3 * 256)) * 256
PLE_DIM = 256

IN_WIDTHS = (A_W, A_W, A_W, B_W, KV_W, KV_W, KV_W, KV_W, KV_W, KV_W, NSA_HEADS * N_NSA_GATES, 2 * D_MODEL)
IN_W = sum(IN_WIDTHS)

kernel_name = "hybrid_dilated_nsa_gated_block"


def rms_norm(x, g):
    xf = x.astype(jnp.float32)
    y = xf * lax.rsqrt(jnp.mean(xf * xf, axis=-1, keepdims=True) + NORM_EPS)
    return (y * g.astype(jnp.float32)).astype(x.dtype)


def rope(x, pos):
    half = HEAD_DIM // 2
    inv = ROPE_THETA ** (-jnp.arange(half, dtype=jnp.float32) / half)
    ang = pos.astype(jnp.float32)[:, None] * inv[None, :]
    shape = (pos.shape[0],) + (1,) * (x.ndim - 3) + (half,)
    cos = jnp.cos(ang).reshape(shape)
    sin = jnp.sin(ang).reshape(shape)
    xf = x.astype(jnp.float32)
    x1, x2 = xf[..., :half], xf[..., half:]
    return jnp.concatenate([x1 * cos - x2 * sin, x2 * cos + x1 * sin], axis=-1).astype(x.dtype)


def masked_softmax(logits, mask):
    return jax.nn.softmax(jnp.where(mask, logits.astype(jnp.float32), NEG_INF), axis=-1)


def dilated_attention(q, k, v):
    B, S = q.shape[0], q.shape[1]
    scale = HEAD_DIM ** -0.5
    rates = jnp.array(DIL_RATES, dtype=jnp.int32)
    offs = rates[:, None] * jnp.arange(DIL_NKEYS, dtype=jnp.int32)[None, :]
    g_ix = jnp.arange(N_DIL)[None, :, None]

    def block(c):
        start = c * QBLK
        pos = start + jnp.arange(QBLK)
        qb = lax.dynamic_slice_in_dim(q, start, QBLK, axis=1)
        kp = pos[:, None, None] - offs[None]
        valid = kp >= 0
        kpc = jnp.maximum(kp, 0)
        kb = k[:, kpc, g_ix]
        vb = v[:, kpc, g_ix]
        logit = jnp.einsum('bqghd,bqgkhd->bqghk', qb, kb).astype(jnp.float32) * scale
        logit = jnp.where(valid[None, :, :, None, :], logit, NEG_INF)
        m = jnp.max(logit, axis=-1, keepdims=True)
        e = jnp.exp(logit - m)
        den = jnp.sum(e, axis=-1, keepdims=True)
        o = jnp.einsum('bqghk,bqgkhd->bqghd', (e / den).astype(v.dtype), vb)
        log_den = (m + jnp.log(den))[..., 0]
        wgt = jax.nn.softmax(log_den, axis=2)
        return jnp.einsum('bqgh,bqghd->bqhd', wgt.astype(o.dtype), o)

    out = lax.map(block, jnp.arange(S // QBLK))
    return jnp.moveaxis(out, 0, 1).reshape(B, S, A_OUT_W)


def compress(kv, pe, w1, w2):
    B, S = kv.shape[0], kv.shape[1]
    nc = (S - CMP_LEN) // CMP_STRIDE + 1
    idx = jnp.arange(nc)[:, None] * CMP_STRIDE + jnp.arange(CMP_LEN)[None, :]
    blk = kv[:, idx] + pe[None, None, :, None, :]
    blk = blk.transpose(0, 1, 3, 2, 4).reshape(B, nc, NSA_KV, CMP_LEN * HEAD_DIM)
    return jax.nn.gelu(blk @ w1) @ w2


def overlap_matrix(nc, ns):
    cs = jnp.arange(nc)[:, None] * CMP_STRIDE
    ss = jnp.arange(ns)[None, :] * SEL_LEN
    ov = jnp.clip(jnp.minimum(cs + CMP_LEN, ss + SEL_LEN) - jnp.maximum(cs, ss), 0, None)
    return ov.astype(jnp.float32) / CMP_LEN


def native_sparse_attention(q_raw, q_rot, k_c, v_c, k_s, v_s, k_w, v_w, gates):
    B, S = q_raw.shape[0], q_raw.shape[1]
    nc = k_c.shape[1]
    ns = S // SEL_LEN
    n_top = min(SEL_TOP, ns)
    scale = HEAD_DIM ** -0.5
    ov = overlap_matrix(nc, ns)
    cmp_end = jnp.arange(nc) * CMP_STRIDE + CMP_LEN - 1
    sblk = jnp.arange(ns)
    ks_blk = k_s.reshape(B, ns, SEL_LEN, NSA_KV, HEAD_DIM).transpose(0, 3, 1, 2, 4)
    vs_blk = v_s.reshape(B, ns, SEL_LEN, NSA_KV, HEAD_DIM).transpose(0, 3, 1, 2, 4)
    pad = ((0, 0), (WIN, 0), (0, 0), (0, 0))
    k_wp = jnp.pad(k_w, pad)
    v_wp = jnp.pad(v_w, pad)
    b_ix = jnp.arange(B)[:, None, None, None]
    g_ix = jnp.arange(NSA_KV)[None, None, :, None]

    def block(c):
        start = c * QBLK
        pos = start + jnp.arange(QBLK)
        qr = lax.dynamic_slice_in_dim(q_raw, start, QBLK, axis=1)
        qo = lax.dynamic_slice_in_dim(q_rot, start, QBLK, axis=1)
        gb = lax.dynamic_slice_in_dim(gates, start, QBLK, axis=1)
        cl = jnp.einsum('bqgjd,bngd->bqgjn', qr, k_c) * scale
        cvalid = cmp_end[None, :] <= pos[:, None]
        has_any = (pos >= CMP_LEN - 1).astype(jnp.float32)
        p_c = masked_softmax(cl, cvalid[None, :, None, None, :]) * has_any[None, :, None, None, None]
        o_c = jnp.einsum('bqgjn,bngd->bqgjd', p_c.astype(v_c.dtype), v_c)
        imp = jnp.einsum('bqgjn,nm->bqgm', p_c, ov)
        cur = pos // SEL_LEN
        forced = ((sblk[None] == 0) | (sblk[None] == cur[:, None]) | (sblk[None] == cur[:, None] - 1)).astype(jnp.float32)
        svalid = sblk[None] * SEL_LEN <= pos[:, None]
        score = jnp.where(svalid[None, :, None, :], imp + FORCE_BONUS * forced[None, :, None, :], NEG_INF)
        _, sel = lax.top_k(score, n_top)
        ksb = ks_blk[b_ix, g_ix, sel]
        vsb = vs_blk[b_ix, g_ix, sel]
        kpos = sel[..., None] * SEL_LEN + jnp.arange(SEL_LEN)
        smask = (kpos <= pos[None, :, None, None, None]).reshape(B, QBLK, NSA_KV, 1, n_top * SEL_LEN)
        sl = jnp.einsum('bqgjd,bqgkld->bqgjkl', qo, ksb) * scale
        sl = sl.reshape(B, QBLK, NSA_KV, NSA_QPG, n_top * SEL_LEN)
        p_s = masked_softmax(sl, smask).reshape(B, QBLK, NSA_KV, NSA_QPG, n_top, SEL_LEN)
        o_s = jnp.einsum('bqgjkl,bqgkld->bqgjd', p_s.astype(vsb.dtype), vsb)
        kwb = lax.dynamic_slice_in_dim(k_wp, start, QBLK + WIN, axis=1)
        vwb = lax.dynamic_slice_in_dim(v_wp, start, QBLK + WIN, axis=1)
        wpos = start - WIN + jnp.arange(QBLK + WIN)
        wmask = (wpos[None] <= pos[:, None]) & (pos[:, None] - wpos[None] < WIN) & (wpos[None] >= 0)
        wl = jnp.einsum('bqgjd,bkgd->bqgjk', qo, kwb) * scale
        p_w = masked_softmax(wl, wmask[None, :, None, None, :])
        o_w = jnp.einsum('bqgjk,bkgd->bqgjd', p_w.astype(vwb.dtype), vwb)
        return gb[..., 0:1] * o_c + gb[..., 1:2] * o_s + gb[..., 2:3] * o_w

    out = lax.map(block, jnp.arange(S // QBLK))
    return jnp.moveaxis(out, 0, 1).reshape(B, S, B_W)


def setup_inputs(seed: int = 0) -> dict:
    key = jax.random.key(seed)
    ks = jax.random.split(key, 22)
    f32 = jnp.float32

    def w(k, shape, fan_in):
        return jax.random.normal(k, shape, f32) * fan_in ** -0.5

    def gain(k):
        return 1.0 + 0.1 * jax.random.normal(k, (DEPTH, D_MODEL), f32)

    return {
        "x": jax.random.normal(ks[0], (BATCH, SEQ, D_MODEL), f32),
        "p": jax.random.normal(ks[1], (DEPTH, BATCH, SEQ, PLE_DIM), f32),
        "g_mix_pre": gain(ks[2]),
        "w_in": w(ks[3], (DEPTH, D_MODEL, IN_W), D_MODEL),
        "pe_ck": 0.5 * jax.random.normal(ks[4], (DEPTH, CMP_LEN, HEAD_DIM), f32),
        "w_ck1": w(ks[5], (DEPTH, CMP_LEN * HEAD_DIM, CMP_HID), CMP_LEN * HEAD_DIM),
        "w_ck2": w(ks[6], (DEPTH, CMP_HID, HEAD_DIM), CMP_HID),
        "pe_cv": 0.5 * jax.random.normal(ks[7], (DEPTH, CMP_LEN, HEAD_DIM), f32),
        "w_cv1": w(ks[8], (DEPTH, CMP_LEN * HEAD_DIM, CMP_HID), CMP_LEN * HEAD_DIM),
        "w_cv2": w(ks[9], (DEPTH, CMP_HID, HEAD_DIM), CMP_HID),
        "w_a": w(ks[10], (DEPTH, A_OUT_W, D_MODEL), A_OUT_W),
        "w_b": w(ks[11], (DEPTH, B_W, D_MODEL), B_W),
        "w_out": w(ks[12], (DEPTH, D_MODEL, D_MODEL), D_MODEL),
        "g_mix_post": gain(ks[13]),
        "g_ffn_pre": gain(ks[14]),
        "w_gu": w(ks[15], (DEPTH, D_MODEL, 2 * D_FF), D_MODEL),
        "w_down": w(ks[16], (DEPTH, D_FF, D_MODEL), D_FF),
        "g_ffn_post": gain(ks[17]),
        "g_ple_pre": gain(ks[18]),
        "w_ple_gate": w(ks[19], (DEPTH, D_MODEL, D_MODEL), D_MODEL),
        "w_ple": w(ks[20], (DEPTH, PLE_DIM, D_MODEL), PLE_DIM),
        "g_ple_post": gain(ks[21]),
    }


def reference(x, p, g_mix_pre, w_in, pe_ck, w_ck1, w_ck2, pe_cv, w_cv1, w_cv2, w_a, w_b, w_out,
              g_mix_post, g_ffn_pre, w_gu, w_down, g_ffn_post, g_ple_pre, w_ple_gate, w_ple, g_ple_post):
    B, S, D = x.shape
    pos = jnp.arange(S)
    splits = []
    acc = 0
    for wd in IN_WIDTHS[:-1]:
        acc += wd
        splits.append(acc)
    for i in range(DEPTH):
        h = rms_norm(x, g_mix_pre[i])
        proj = h @ w_in[i]
        (qa, ka, va, qb, kc, vc, ksl, vsl, kwn, vwn, g_nsa, g_mix) = jnp.split(proj, splits, axis=-1)
        a_shape = (B, S, N_DIL, DIL_HEADS, HEAD_DIM)
        y_a = dilated_attention(rope(qa.reshape(a_shape), pos), rope(ka.reshape(a_shape), pos),
                                va.reshape(a_shape)) @ w_a[i]
        kv_shape = (B, S, NSA_KV, HEAD_DIM)
        q_raw = qb.reshape(B, S, NSA_KV, NSA_QPG, HEAD_DIM)
        k_c = compress(kc.reshape(kv_shape), pe_ck[i], w_ck1[i], w_ck2[i])
        v_c = compress(vc.reshape(kv_shape), pe_cv[i], w_cv1[i], w_cv2[i])
        gates = jax.nn.sigmoid(g_nsa.reshape(B, S, NSA_KV, NSA_QPG, N_NSA_GATES))
        y_b = native_sparse_attention(q_raw, rope(q_raw, pos), k_c, v_c,
                                      rope(ksl.reshape(kv_shape), pos), vsl.reshape(kv_shape),
                                      rope(kwn.reshape(kv_shape), pos), vwn.reshape(kv_shape),
                                      gates) @ w_b[i]
        gate_a, gate_b = jnp.split(jax.nn.sigmoid(g_mix), 2, axis=-1)
        mixed = (gate_a * y_a + gate_b * y_b) @ w_out[i]
        x = x + rms_norm(mixed, g_mix_post[i])
        h = rms_norm(x, g_ffn_pre[i])
        gt, up = jnp.split(h @ w_gu[i], 2, axis=-1)
        x = x + rms_norm((jax.nn.silu(gt) * up) @ w_down[i], g_ffn_post[i])
        ple = (p[i] @ w_ple[i]) * jax.nn.sigmoid(rms_norm(x, g_ple_pre[i]) @ w_ple_gate[i])
        x = x + rms_norm(ple, g_ple_post[i])
    return x
```

```cpp
#include <hip/hip_runtime.h>
#include <stdint.h>

namespace hk {
typedef unsigned short bf16_t;
typedef short bf16x8 __attribute__((ext_vector_type(8)));
typedef float f32x4 __attribute__((ext_vector_type(4)));
typedef unsigned u32x4 __attribute__((ext_vector_type(4)));
typedef unsigned u32x2 __attribute__((ext_vector_type(2)));
typedef int v4i __attribute__((ext_vector_type(4)));
typedef int v8i __attribute__((ext_vector_type(8)));

constexpr int S = 8192, DM = 4096, HD = 128;
constexpr int IN_W = 17968, N1P = 39 * 256;
constexpr int DFF = 11008, NGU = 2 * DFF;
constexpr int PLE = 256;
constexpr int LDK = DM + 64;
constexpr int LD8 = 4224;
constexpr int LDA8 = DFF + 128;
constexpr float W8SCALE = 64.0f;
constexpr int KAB = 512 + 2048;
constexpr int NC = 511, NCP = 512, NSEL = 128;
constexpr float EPS = 1e-6f;
constexpr float QSCALE = 0.08838834764831845f;
constexpr int C_QA = 0, C_KA = 1536, C_VA = 3072, C_QB = 4608, C_KC = 6656, C_VC = 7168, C_KS = 7680, C_VS = 8192, C_KW = 8704, C_VW = 9216, C_GN = 9728, C_GM = 9776;

constexpr size_t al(size_t x) { return (x + 255) & ~(size_t)255; }
constexpr size_t WS_CTL = 0;
constexpr size_t WS_R2 = 32768;
constexpr size_t WS_W1T = 65536;
constexpr size_t WS_WGUT = WS_W1T + al((size_t)N1P * LDK * 2);
constexpr size_t WS_WDT = WS_WGUT + al((size_t)NGU * LDK * 2);
constexpr size_t WS_WOT = WS_WDT + al((size_t)DM * DFF * 2);
constexpr size_t WS_WGT = WS_WOT + al((size_t)DM * LDK * 2);
constexpr size_t WS_WABT = WS_WGT + al((size_t)DM * LDK * 2);
constexpr size_t WS_WPT = WS_WABT + al((size_t)DM * KAB * 2);
constexpr size_t WS_WCK1T = WS_WPT + al((size_t)DM * PLE * 2);
constexpr size_t WS_WCV1T = WS_WCK1T + al((size_t)128 * 4096 * 2);
constexpr size_t WS_ROPEC = WS_WCV1T + al((size_t)128 * 4096 * 2);
constexpr size_t WS_ROPES = WS_ROPEC + al((size_t)S * 64 * 4);
constexpr size_t WS_CB = WS_ROPES + al((size_t)S * 64 * 4);
constexpr size_t WS_HB = WS_CB + al(256 * 4);
constexpr size_t WS_PB = WS_HB + al((size_t)S * LDK * 2);
constexpr size_t WS_QA = WS_PB + al((size_t)S * PLE * 2);
constexpr size_t WS_KA = WS_QA + al((size_t)S * 1536 * 2);
constexpr size_t WS_VA = WS_KA + al((size_t)S * 1536 * 2);
constexpr size_t WS_QBR = WS_VA + al((size_t)S * 1536 * 2);
constexpr size_t WS_QBT = WS_QBR + al((size_t)S * 2048 * 2);
constexpr size_t WS_KC = WS_QBT + al((size_t)S * 2048 * 2);
constexpr size_t WS_VC = WS_KC + al((size_t)S * 512 * 2);
constexpr size_t WS_KS = WS_VC + al((size_t)S * 512 * 2);
constexpr size_t WS_VS = WS_KS + al((size_t)S * 512 * 2);
constexpr size_t WS_KW = WS_VS + al((size_t)S * 512 * 2);
constexpr size_t WS_VW = WS_KW + al((size_t)S * 512 * 2);
constexpr size_t WS_GMIX = WS_VW + al((size_t)S * 512 * 2);
constexpr size_t WS_PROJ_END = WS_GMIX + al((size_t)S * 8192 * 2);
constexpr size_t WS_ACT = WS_QA;
static_assert(WS_ACT + (size_t)S * DFF * 2 <= WS_PROJ_END, "act alias");
constexpr size_t WS_GNSA = WS_PROJ_END;
constexpr size_t WS_KCC = WS_GNSA + al((size_t)S * 48 * 4);
constexpr size_t WS_VCC = WS_KCC + al((size_t)4 * NCP * 128 * 2);
constexpr size_t WS_YC = WS_VCC + al((size_t)4 * NCP * 128 * 2);
constexpr size_t WS_MG = WS_YC + al((size_t)S * KAB * 2);
constexpr size_t WS_MX = WS_MG + al((size_t)S * LDK * 2);
constexpr size_t WS_PART = WS_MX + al((size_t)S * DM * 2);
constexpr size_t WS_CBP = WS_PART + al((size_t)S * 64 * 4);
constexpr size_t WS_XR = WS_CBP + al((size_t)256 * 256 * 4);
constexpr size_t WS_W1G8 = WS_XR + al((size_t)S * DM * 2);
constexpr size_t WS_H8 = WS_W1G8 + al((size_t)8192 * 4224);
constexpr size_t WS_END = WS_H8 + al((size_t)S * 4224);

#define PG8_LAS __attribute__((address_space(3)))
__device__ __forceinline__ bf16_t f2bf(float f) { unsigned u = __float_as_uint(f); u += 0x7FFFu + ((u >> 16) & 1u); return (bf16_t)(u >> 16); }
__device__ __forceinline__ float bf2f(bf16_t b) { return __uint_as_float(((unsigned)b) << 16); }
__device__ __forceinline__ unsigned pk2(float lo, float hi) { return (unsigned)f2bf(lo) | ((unsigned)f2bf(hi) << 16); }
__device__ __forceinline__ float sigmoidf_(float x) { return __builtin_amdgcn_rcpf(1.0f + __expf(-x)); }
__device__ __forceinline__ float wave_sum(float v) { for (int o = 32; o >= 1; o >>= 1) v += __shfl_xor(v, o); return v; }
__device__ __forceinline__ float wave_max(float v) { for (int o = 32; o >= 1; o >>= 1) v = fmaxf(v, __shfl_xor(v, o)); return v; }
__host__ __device__ __forceinline__ int perm32(int rho) { const int n = rho >> 4, i = rho & 15; return 8 * (i >> 2) + 4 * n + (i & 3); }
__device__ __forceinline__ void unpack8(u32x4 w, float (&v)[8]) {
    v[0] = __uint_as_float(w.x << 16); v[1] = __uint_as_float(w.x & 0xffff0000u); v[2] = __uint_as_float(w.y << 16); v[3] = __uint_as_float(w.y & 0xffff0000u);
    v[4] = __uint_as_float(w.z << 16); v[5] = __uint_as_float(w.z & 0xffff0000u); v[6] = __uint_as_float(w.w << 16); v[7] = __uint_as_float(w.w & 0xffff0000u);
}
__device__ __forceinline__ u32x4 pack8(const float (&v)[8]) { u32x4 w; w.x = pk2(v[0], v[1]); w.y = pk2(v[2], v[3]); w.z = pk2(v[4], v[5]); w.w = pk2(v[6], v[7]); return w; }

struct Ctx {
    const float* x; const float* p; const float* g_mix_pre; const float* w_in; const float* pe_ck; const float* w_ck1; const float* w_ck2;
    const float* pe_cv; const float* w_cv1; const float* w_cv2; const float* w_a; const float* w_b; const float* w_out; const float* g_mix_post;
    const float* g_ffn_pre; const float* w_gu; const float* w_down; const float* g_ffn_post; const float* g_ple_pre; const float* w_ple_gate;
    const float* w_ple; const float* g_ple_post; float* out; unsigned char* ws;
};
#define WSP(T, off) ((T*)(c.ws + (off)))

struct MapIn {
    __device__ __forceinline__ int operator()(int n) const {
        const int t = n >> 8, cc = n & 255;
        auto rope = [&](int base, int tt) { const int half = cc >> 7, c7 = cc & 127; return base + (2 * tt + (c7 >> 6)) * 128 + half * 64 + (c7 & 63); };
        if (t < 6) return rope(C_QA, t);
        if (t < 12) return rope(C_KA, t - 6);
        if (t < 18) return C_VA + (t - 12) * 256 + cc;
        if (t < 26) return rope(C_QB, t - 18);
        if (t < 28) return C_KC + (t - 26) * 256 + cc;
        if (t < 30) return C_VC + (t - 28) * 256 + cc;
        if (t < 32) return rope(C_KS, t - 30);
        if (t < 34) return C_VS + (t - 32) * 256 + cc;
        if (t < 36) return rope(C_KW, t - 34);
        if (t < 38) return C_VW + (t - 36) * 256 + cc;
        return cc < 48 ? C_GN + cc : -1;
    }
};
struct MapGM { __device__ __forceinline__ int operator()(int n) const { return C_GM + n; } };
struct MapGU { __device__ __forceinline__ int operator()(int n) const { const int t = n >> 8, cc = n & 255; return cc < 128 ? t * 128 + cc : DFF + t * 128 + (cc - 128); } };
struct MapId { __device__ __forceinline__ int operator()(int n) const { return n; } };

__device__ __forceinline__ unsigned pk4_fp8(float a, float b, float c, float d) { int w = 0; w = __builtin_amdgcn_cvt_pk_fp8_f32(a, b, w, false); w = __builtin_amdgcn_cvt_pk_fp8_f32(c, d, w, true); return (unsigned)w; }
template <bool F8, class Map>
__device__ __forceinline__ void convert_wt(const float* __restrict__ W, int K, int ldw, bf16_t* __restrict__ Bt, int ldb, int koff, int N, Map map, PG8_LAS unsigned char* lds, int gw, int nw) {
    const int lane = threadIdx.x & 63, wid = __builtin_amdgcn_readfirstlane((int)(threadIdx.x >> 6));
    constexpr int KI = F8 ? 128 : 64;
    const int tn = N / 64, tk = K / KI, ng = (tn + 3) / 4, nt = ng * tk * 4;
    PG8_LAS unsigned char* wl = lds + wid * 9216;
    for (int t = gw; t < nt; t += nw) {
        const int nblk = (t / (4 * tk)) * 4 + (t & 3), k0 = ((t >> 2) % tk) * KI, n0 = nblk * 64;
        if (nblk >= tn) continue;
        const int src = map(n0 + lane);
#pragma unroll
        for (int half = 0; half < (F8 ? 2 : 1); ++half) {
            const float* p = W + (size_t)(k0 + half * 64) * ldw + (src >= 0 ? src : 0);
            float v[64];
#pragma unroll
            for (int kk = 0; kk < 64; ++kk) v[kk] = __builtin_nontemporal_load(p + (size_t)kk * ldw);
            if (src < 0) {
#pragma unroll
                for (int kk = 0; kk < 64; ++kk) v[kk] = 0.f; }
            if (F8) {
#pragma unroll
                for (int j = 0; j < 4; ++j) { u32x4 w; w.x = pk4_fp8(v[16 * j] * W8SCALE, v[16 * j + 1] * W8SCALE, v[16 * j + 2] * W8SCALE, v[16 * j + 3] * W8SCALE); w.y = pk4_fp8(v[16 * j + 4] * W8SCALE, v[16 * j + 5] * W8SCALE, v[16 * j + 6] * W8SCALE, v[16 * j + 7] * W8SCALE);
                    w.z = pk4_fp8(v[16 * j + 8] * W8SCALE, v[16 * j + 9] * W8SCALE, v[16 * j + 10] * W8SCALE, v[16 * j + 11] * W8SCALE); w.w = pk4_fp8(v[16 * j + 12] * W8SCALE, v[16 * j + 13] * W8SCALE, v[16 * j + 14] * W8SCALE, v[16 * j + 15] * W8SCALE);
                    *(PG8_LAS u32x4*)(wl + lane * 144 + half * 64 + j * 16) = w; }
            } else {
#pragma unroll
                for (int j = 0; j < 8; ++j) { u32x4 w; w.x = pk2(v[8 * j], v[8 * j + 1]); w.y = pk2(v[8 * j + 2], v[8 * j + 3]); w.z = pk2(v[8 * j + 4], v[8 * j + 5]); w.w = pk2(v[8 * j + 6], v[8 * j + 7]);
                    *(PG8_LAS u32x4*)(wl + lane * 144 + j * 16) = w; }
            }
        }
        asm volatile("s_waitcnt lgkmcnt(0)" ::: "memory");
        bf16_t* o = Bt + (size_t)(n0 + (lane >> 3)) * ldb + koff + (F8 ? (k0 >> 1) : k0) + (lane & 7) * 8;
#pragma unroll
        for (int i = 0; i < 8; ++i) { const u32x4 w = *(PG8_LAS const u32x4*)(wl + (i * 8 + (lane >> 3)) * 144 + (lane & 7) * 16); *(u32x4*)(o + (size_t)i * 8 * ldb) = w; }
        asm volatile("s_waitcnt lgkmcnt(0)" ::: "memory");
    }
}

__device__ __forceinline__ void rmsnorm_rows(const float* __restrict__ x, const float* __restrict__ g, bf16_t* __restrict__ o, unsigned char* __restrict__ o8, int bid, int nb) {
    const int wid = threadIdx.x >> 6, lane = threadIdx.x & 63, nw = blockDim.x >> 6;
    for (int row = bid * nw + wid; row < S; row += nb * nw) {
        const float* xr = x + (size_t)row * DM; f32x4 v[16]; float ss = 0.f;
#pragma unroll
        for (int i = 0; i < 16; ++i) { v[i] = *(const f32x4*)(xr + i * 256 + lane * 4); ss += v[i][0] * v[i][0] + v[i][1] * v[i][1] + v[i][2] * v[i][2] + v[i][3] * v[i][3]; }
        ss = wave_sum(ss); const float r = rsqrtf(ss * (1.0f / DM) + EPS);
#pragma unroll
        for (int i = 0; i < 16; ++i) { const f32x4 gg = *(const f32x4*)(g + i * 256 + lane * 4); u32x2 w; w.x = pk2(v[i][0] * r * gg[0], v[i][1] * r * gg[1]); w.y = pk2(v[i][2] * r * gg[2], v[i][3] * r * gg[3]);
            *(u32x2*)(o + (size_t)row * LDK + i * 256 + lane * 4) = w;
            *(unsigned*)(o8 + (size_t)row * LD8 + i * 256 + lane * 4) = pk4_fp8(v[i][0] * r * gg[0], v[i][1] * r * gg[1], v[i][2] * r * gg[2], v[i][3] * r * gg[3]); }
    }
}

struct EpiIn {
    unsigned char* ws;
    __device__ __forceinline__ void rope_store(bf16_t* dst, int ld, int head, int row, int c8, const float (&lo)[8], const float (&hi)[8], bf16_t* raw) const {
        const int hl = c8 >> 6, i0 = c8 & 63; const float* ct = (const float*)(ws + WS_ROPEC) + (size_t)row * 64 + i0; const float* st = (const float*)(ws + WS_ROPES) + (size_t)row * 64 + i0;
        float a[8], b[8];
#pragma unroll
        for (int j = 0; j < 8; ++j) { const float cs = ct[j], sn = st[j]; a[j] = lo[j] * cs - hi[j] * sn; b[j] = hi[j] * cs + lo[j] * sn; }
        bf16_t* o = dst + (size_t)row * ld + (head + hl) * 128 + i0; *(u32x4*)o = pack8(a); *(u32x4*)(o + 64) = pack8(b);
        if (raw) { bf16_t* r = raw + (size_t)row * ld + (head + hl) * 128 + i0; *(u32x4*)r = pack8(lo); *(u32x4*)(r + 64) = pack8(hi); }
    }
    __device__ __forceinline__ void plain_store(bf16_t* dst, int ld, int col0, int row, int c8, const float (&lo)[8], const float (&hi)[8]) const {
        bf16_t* o = dst + (size_t)row * ld + col0 + c8; *(u32x4*)o = pack8(lo); *(u32x4*)(o + 128) = pack8(hi);
    }
    __device__ __forceinline__ float rowscale(int) const { return 1.f; }
    __device__ __forceinline__ void apply(int row, int t, int c8, const float (&lo)[8], const float (&hi)[8], float) const {
        if (t < 6) rope_store((bf16_t*)(ws + WS_QA), 1536, 2 * t, row, c8, lo, hi, nullptr);
        else if (t < 12) rope_store((bf16_t*)(ws + WS_KA), 1536, 2 * (t - 6), row, c8, lo, hi, nullptr);
        else if (t < 18) plain_store((bf16_t*)(ws + WS_VA), 1536, (t - 12) * 256, row, c8, lo, hi);
        else if (t < 26) rope_store((bf16_t*)(ws + WS_QBT), 2048, 2 * (t - 18), row, c8, lo, hi, (bf16_t*)(ws + WS_QBR));
        else if (t < 28) plain_store((bf16_t*)(ws + WS_KC), 512, (t - 26) * 256, row, c8, lo, hi);
        else if (t < 30) plain_store((bf16_t*)(ws + WS_VC), 512, (t - 28) * 256, row, c8, lo, hi);
        else if (t < 32) rope_store((bf16_t*)(ws + WS_KS), 512, 2 * (t - 30), row, c8, lo, hi, nullptr);
        else if (t < 34) plain_store((bf16_t*)(ws + WS_VS), 512, (t - 32) * 256, row, c8, lo, hi);
        else if (t < 36) rope_store((bf16_t*)(ws + WS_KW), 512, 2 * (t - 34), row, c8, lo, hi, nullptr);
        else if (t < 38) plain_store((bf16_t*)(ws + WS_VW), 512, (t - 36) * 256, row, c8, lo, hi);
        else if (c8 < 48) { float* o = (float*)(ws + WS_GNSA) + (size_t)row * 48 + c8;
#pragma unroll
            for (int j = 0; j < 8; ++j) o[j] = sigmoidf_(lo[j]); }
    }
};
struct EpiGate8 {
    bf16_t* gm;
    __device__ __forceinline__ float rowscale(int) const { return 1.f; }
    __device__ __forceinline__ void apply(int row, int pn, int c8, const float (&lo)[8], const float (&hi)[8], float) const {
        float a[8], b[8];
#pragma unroll
        for (int j = 0; j < 8; ++j) { a[j] = sigmoidf_(lo[j] * (1.0f / W8SCALE)); b[j] = sigmoidf_(hi[j] * (1.0f / W8SCALE)); }
        bf16_t* o = gm + (size_t)row * 8192 + pn * 256 + c8; *(u32x4*)o = pack8(a); *(u32x4*)(o + 128) = pack8(b);
    }
};
struct EpiGateA {
    const bf16_t* gm; bf16_t* out;
    __device__ __forceinline__ float rowscale(int) const { return 1.f; }
    __device__ __forceinline__ void apply(int row, int pn, int c8, const float (&lo)[8], const float (&hi)[8], float) const {
        float ga[8], a[8], b[8]; const int col = pn * 256 + c8;
        unpack8(__builtin_nontemporal_load((const u32x4*)(gm + (size_t)row * 8192 + col)), ga);
#pragma unroll
        for (int j = 0; j < 8; ++j) a[j] = lo[j] * ga[j];
        unpack8(__builtin_nontemporal_load((const u32x4*)(gm + (size_t)row * 8192 + col + 128)), ga);
#pragma unroll
        for (int j = 0; j < 8; ++j) b[j] = hi[j] * ga[j];
        bf16_t* o = out + (size_t)row * LDK + col; *(u32x4*)o = pack8(a); *(u32x4*)(o + 128) = pack8(b);
    }
};
struct EpiGateB {
    const bf16_t* gm; bf16_t* out;
    __device__ __forceinline__ float rowscale(int) const { return 1.f; }
    __device__ __forceinline__ void apply(int row, int pn, int c8, const float (&lo)[8], const float (&hi)[8], float) const {
        float gb[8], t[8], a[8], b[8]; const int col = pn * 256 + c8; bf16_t* o = out + (size_t)row * LDK + col;
        unpack8(__builtin_nontemporal_load((const u32x4*)(gm + (size_t)row * 8192 + 4096 + col)), gb); unpack8(*(const u32x4*)o, t);
#pragma unroll
        for (int j = 0; j < 8; ++j) a[j] = t[j] + lo[j] * gb[j];
        unpack8(__builtin_nontemporal_load((const u32x4*)(gm + (size_t)row * 8192 + 4096 + col + 128)), gb); unpack8(*(const u32x4*)(o + 128), t);
#pragma unroll
        for (int j = 0; j < 8; ++j) b[j] = t[j] + hi[j] * gb[j];
        *(u32x4*)o = pack8(a); *(u32x4*)(o + 128) = pack8(b);
    }
};
struct EpiSS {
    bf16_t* out; float* part; const bf16_t* P; float sc; const float* r2;
    __device__ __forceinline__ float rowscale(int row) const { return r2 ? sc * r2[row] : sc; }
    __device__ __forceinline__ void apply(int row, int pn, int c8, const float (&lo)[8], const float (&hi)[8], float rs) const {
        float a[8], b[8];
        if (P) { float pa[8], pb[8]; unpack8(__builtin_nontemporal_load((const u32x4*)(P + (size_t)row * LDK + pn * 256 + c8)), pa); unpack8(__builtin_nontemporal_load((const u32x4*)(P + (size_t)row * LDK + pn * 256 + 128 + c8)), pb);
#pragma unroll
            for (int j = 0; j < 8; ++j) { a[j] = pa[j] * sigmoidf_(lo[j] * rs); b[j] = pb[j] * sigmoidf_(hi[j] * rs); } }
        else {
#pragma unroll
            for (int j = 0; j < 8; ++j) { a[j] = lo[j] * rs; b[j] = hi[j] * rs; } }
        float s = 0.f;
#pragma unroll
        for (int j = 0; j < 8; ++j) s += a[j] * a[j] + b[j] * b[j];
        s += __shfl_xor(s, 16); s += __shfl_xor(s, 32);
        if ((threadIdx.x & 63) < 16) part[(size_t)row * 64 + pn * 4 + (c8 >> 5)] = s;
        bf16_t* o = out + (size_t)row * DM + pn * 256 + c8; *(u32x4*)o = pack8(a); *(u32x4*)(o + 128) = pack8(b);
    }
};
struct EpiSwiglu {
    bf16_t* act; const float* r2;
    __device__ __forceinline__ float rowscale(int row) const { return r2[row] * (1.0f / W8SCALE); }
    __device__ __forceinline__ void apply(int row, int pn, int c8, const float (&lo)[8], const float (&hi)[8], float rs) const {
        float a[8];
#pragma unroll
        for (int j = 0; j < 8; ++j) { const float gv = lo[j] * rs, uv = hi[j] * rs; a[j] = gv * sigmoidf_(gv) * uv; }
        u32x2 w; w.x = pk4_fp8(a[0], a[1], a[2], a[3]); w.y = pk4_fp8(a[4], a[5], a[6], a[7]); *(u32x2*)((unsigned char*)act + (size_t)row * LDA8 + pn * 128 + c8) = w;
    }
};
struct EpiPlain {
    bf16_t* out;
    __device__ __forceinline__ float rowscale(int) const { return 1.f; }
    __device__ __forceinline__ void apply(int row, int pn, int c8, const float (&lo)[8], const float (&hi)[8], float) const {
        bf16_t* o = out + (size_t)row * LDK + pn * 256 + c8; *(u32x4*)o = pack8(lo); *(u32x4*)(o + 128) = pack8(hi);
    }
};

namespace pg8 {
constexpr int BM = 256, BK = 64, HALF = 128, HTB = HALF * BK * 2, STAGE_BYTES = 8 * HTB, NXCD = 8, WGM = 8;
__host__ __device__ __forceinline__ int lds_byte(int r, int c) { const int st = (r >> 4) * 2 + (c >> 5), rr = r & 15, cc = c & 31, ob = rr * 64 + cc * 2; return st * 1024 + (ob ^ (((ob >> 9) & 1) << 5)); }
__host__ __device__ __forceinline__ void stage_rc(int b, int& R, int& C) { const int st = b / 1024, sb = b % 1024, swz = sb ^ (((sb >> 9) & 1) << 5); R = (st >> 1) * 16 + swz / 64; C = (st & 1) * 32 + (swz % 64) / 2; }
struct Unit { int pm, pn; };
struct Gemm { const bf16_t* A; const bf16_t* Bt; int M, N, K, lda, ldb; };
struct StaticOrder {
    int nM, nN, nwg, G, c;
    __host__ __device__ void init(int M, int N, int G_, int c_) { nM = M / BM; nN = N / BM; nwg = nM * nN; G = G_; c = c_; }
    __host__ __device__ bool next(int i, Unit& u) const {
        const long L = (long)i * G + c; if (L >= nwg) return false;
        int wgid = (int)L; { const int q = nwg / NXCD, r = nwg % NXCD, xcd = wgid % NXCD, off = wgid / NXCD; wgid = (xcd < r ? xcd * (q + 1) : r * (q + 1) + (xcd - r) * q) + off; }
        const int nig = WGM * nN, gid = wgid / nig, fm = gid * WGM, gsz = (nM - fm) < WGM ? (nM - fm) : WGM;
        u.pm = fm + ((wgid % nig) % gsz); u.pn = (wgid % nig) / gsz; return true;
    }
};
template <class Epi>
__device__ __forceinline__ void run_epi(const Epi& E, const f32x4 (&acc)[2][2][4][2], const Unit& u, int wr, int wc, int fr, int fq) {
    float rs[2][4];
#pragma unroll
    for (int ai = 0; ai < 2; ++ai)
#pragma unroll
        for (int m = 0; m < 4; ++m) rs[ai][m] = E.rowscale(u.pm * BM + ai * HALF + wr * 64 + m * 16 + fr);
#pragma unroll
    for (int ai = 0; ai < 2; ++ai)
#pragma unroll
        for (int m = 0; m < 4; ++m) {
            float lo[8], hi[8];
#pragma unroll
            for (int j = 0; j < 4; ++j) { lo[j] = acc[ai][0][m][0][j]; lo[4 + j] = acc[ai][0][m][1][j]; hi[j] = acc[ai][1][m][0][j]; hi[4 + j] = acc[ai][1][m][1][j]; }
            E.apply(u.pm * BM + ai * HALF + wr * 64 + m * 16 + fr, u.pn, wc * 32 + fq * 8, lo, hi, rs[ai][m]);
            if (m == 3) asm volatile("" ::: "memory");
        }
}
template <class Epi, class Sched, bool F8 = false>
__device__ __forceinline__ void gemm_phase(PG8_LAS unsigned char* lds, const Gemm g, const Sched& S, const Epi& E) {
    const int tid = threadIdx.x, wid = __builtin_amdgcn_readfirstlane(tid >> 6), lane = tid & 63, wr = wid >> 2, wc = wid & 3, fr = lane & 15, fq = lane >> 4;
    const int K = g.K, nt = K / BK;
    unsigned voffA[2], voffB[2];
#pragma unroll
    for (int i = 0; i < 2; ++i) { int R, C; stage_rc(tid * 16 + i * 8192, R, C); const int Rb = (R & ~31) + perm32(R & 31);
        voffA[i] = (unsigned)(R * g.lda + C) * 2u; voffB[i] = (unsigned)(Rb * g.ldb + C) * 2u; }
    const size_t kstep = (size_t)(BK * 2);
    const size_t hstepA = (size_t)HALF * g.lda * 2, hstepB = (size_t)HALF * g.ldb * 2;
    const size_t tstepA = 2 * hstepA, tstepB = 2 * hstepB;
    const unsigned ldsw = (unsigned)wid * 1024u;
    const int aoff = lds_byte(wr * 64 + fr, fq * 8), boff = lds_byte(wc * 32 + fr, fq * 8);
#define PG8_SA(b, h) (((b) * 2 + (h)) * HTB)
#define PG8_SB(b, h) ((4 + (b) * 2 + (h)) * HTB)
    const __amdgpu_buffer_rsrc_t rsA = __builtin_amdgcn_make_buffer_rsrc((void*)g.A, 0, 0x7fffffff, 0x00020000), rsB = __builtin_amdgcn_make_buffer_rsrc((void*)g.Bt, 0, 0x7fffffff, 0x00020000);
#define PG8_STAGE(bufoff, gbase, voff) do { const bool isA_ = ((voff) == voffA); const int so_ = (int)((const char*)(gbase) - (isA_ ? (const char*)g.A : (const char*)g.Bt)); \
        _Pragma("unroll") for (int _i = 0; _i < 2; ++_i) \
        __builtin_amdgcn_raw_ptr_buffer_load_lds(isA_ ? rsA : rsB, (PG8_LAS unsigned*)(lds + (bufoff) + ldsw + _i * 8192), 16, (int)(voff)[_i], so_, 0, 0); } while (0)
#define PG8_LD16(off) (*(const PG8_LAS v4i*)(lds + (off)))
#define PG8_LDA(dst, b, h) do { _Pragma("unroll") for (int m = 0; m < 4; ++m) { if constexpr (F8) dst##8[m] = __builtin_shufflevector(PG8_LD16(PG8_SA(b, h) + aoff + m * 2048), PG8_LD16(PG8_SA(b, h) + aoff + m * 2048 + 1024), 0, 1, 2, 3, 4, 5, 6, 7); \
        else { _Pragma("unroll") for (int k = 0; k < 2; ++k) dst[m][k] = *(const PG8_LAS bf16x8*)(lds + PG8_SA(b, h) + aoff + m * 2048 + k * 1024); } } } while (0)
#define PG8_LDB(dst, b, h) do { _Pragma("unroll") for (int n = 0; n < 2; ++n) { if constexpr (F8) dst##8[n] = __builtin_shufflevector(PG8_LD16(PG8_SB(b, h) + boff + n * 2048), PG8_LD16(PG8_SB(b, h) + boff + n * 2048 + 1024), 0, 1, 2, 3, 4, 5, 6, 7); \
        else { _Pragma("unroll") for (int k = 0; k < 2; ++k) dst[n][k] = *(const PG8_LAS bf16x8*)(lds + PG8_SB(b, h) + boff + n * 2048 + k * 1024); } } } while (0)
#define PG8_MMA(ai, bj, At, Bt) do { __builtin_amdgcn_s_setprio(1); _Pragma("unroll") for (int m = 0; m < 4; ++m) _Pragma("unroll") for (int n = 0; n < 2; ++n) { \
        if constexpr (F8) asm volatile("v_mfma_scale_f32_16x16x128_f8f6f4 %0, %1, %2, %0, %3, %3 op_sel_hi:[0,0,0]" : "+v"(acc[ai][bj][m][n]) : "v"(Bt##8[n]), "v"(At##8[m]), "v"(sc8));   \
        else { _Pragma("unroll") for (int k = 0; k < 2; ++k) acc[ai][bj][m][n] = __builtin_amdgcn_mfma_f32_16x16x32_bf16(Bt[n][k], At[m][k], acc[ai][bj][m][n], 0, 0, 0); } } \
        __builtin_amdgcn_s_setprio(0); } while (0)
#define PG8_WAIT_V(n) asm volatile("s_waitcnt vmcnt(" #n ")" ::: "memory")
#define PG8_WAIT_L(n) asm volatile("s_waitcnt lgkmcnt(" #n ")" ::: "memory")
#define PG8_BAR __builtin_amdgcn_s_barrier()
#define PG8_SCHED __builtin_amdgcn_sched_barrier(0)
    Unit cur, nxt; int ui = 0;
    if (!S.next(0, cur)) return;
    f32x4 acc[2][2][4][2];
#pragma unroll
    for (int a = 0; a < 2; ++a)
#pragma unroll
        for (int b = 0; b < 2; ++b)
#pragma unroll
            for (int m = 0; m < 4; ++m)
#pragma unroll
                for (int n = 0; n < 2; ++n) acc[a][b][m][n] = (f32x4){0.f, 0.f, 0.f, 0.f};
    const int sc8 = 0x7f7f7f7f; bf16x8 At[4][2], B0[2][2], B1[2][2]; v8i At8[4], B08[2], B18[2];
    const char* cA = (const char*)g.A + (size_t)cur.pm * tstepA; const char* cB = (const char*)g.Bt + (size_t)cur.pn * tstepB;
    PG8_STAGE(PG8_SB(0, 0), cB, voffB); PG8_STAGE(PG8_SA(0, 0), cA, voffA); PG8_STAGE(PG8_SB(0, 1), cB + hstepB, voffB); PG8_STAGE(PG8_SA(0, 1), cA + hstepA, voffA);
    if (wr == 1) PG8_BAR;
    PG8_WAIT_V(4); PG8_BAR;
    PG8_STAGE(PG8_SB(1, 0), cB + kstep, voffB); PG8_STAGE(PG8_SA(1, 0), cA + kstep, voffA); PG8_STAGE(PG8_SB(1, 1), cB + hstepB + kstep, voffB);
    PG8_WAIT_V(6); PG8_BAR;
    for (;;) {
        const bool has_next = S.next(ui + 1, nxt);
        const char* nA = has_next ? (const char*)g.A + (size_t)nxt.pm * tstepA : cA; const char* nB = has_next ? (const char*)g.Bt + (size_t)nxt.pn * tstepB : cB;
        for (int t = 0; t < nt; t += 2) {
            const bool last = (t == nt - 2);
            const char* a1 = cA + (size_t)(t + 1) * kstep;
            const char* a2 = last ? nA : cA + (size_t)(t + 2) * kstep; const char* b2 = last ? nB : cB + (size_t)(t + 2) * kstep;
            const char* a3 = a2 + kstep; const char* b3 = b2 + kstep;
            PG8_LDB(B0, 0, 0); PG8_SCHED; PG8_LDA(At, 0, 0); PG8_STAGE(PG8_SA(1, 1), a1 + hstepA, voffA);
            PG8_WAIT_L(8); PG8_BAR; PG8_WAIT_L(0); PG8_MMA(0, 0, At, B0); PG8_BAR; PG8_SCHED;
            PG8_LDB(B1, 0, 1); PG8_STAGE(PG8_SB(0, 0), b2, voffB);
            PG8_BAR; PG8_WAIT_L(0); PG8_MMA(0, 1, At, B1); PG8_BAR;
            PG8_LDA(At, 0, 1); PG8_STAGE(PG8_SA(0, 0), a2, voffA);
            PG8_BAR; PG8_WAIT_L(0); PG8_MMA(1, 0, At, B0); PG8_BAR; PG8_SCHED;
            PG8_STAGE(PG8_SB(0, 1), b2 + hstepB, voffB);
            PG8_WAIT_V(6); PG8_BAR; PG8_MMA(1, 1, At, B1); PG8_BAR;
            PG8_LDB(B0, 1, 0); PG8_SCHED; PG8_LDA(At, 1, 0); PG8_STAGE(PG8_SA(0, 1), a2 + hstepA, voffA);
            PG8_WAIT_L(8); PG8_BAR; PG8_WAIT_L(0); PG8_MMA(0, 0, At, B0); PG8_BAR; PG8_SCHED;
            PG8_LDB(B1, 1, 1); PG8_STAGE(PG8_SB(1, 0), b3, voffB);
            PG8_BAR; PG8_WAIT_L(0); PG8_MMA(0, 1, At, B1); PG8_BAR;
            PG8_LDA(At, 1, 1); PG8_STAGE(PG8_SA(1, 0), a3, voffA);
            PG8_BAR; PG8_WAIT_L(0); PG8_MMA(1, 0, At, B0); PG8_BAR; PG8_SCHED;
            PG8_STAGE(PG8_SB(1, 1), b3 + hstepB, voffB);
            PG8_WAIT_V(6); PG8_BAR; PG8_MMA(1, 1, At, B1); PG8_BAR;
        }
        if constexpr (F8) asm volatile("s_nop 15\n\ts_nop 15" ::: "memory");
        run_epi(E, acc, cur, wr, wc, fr, fq);
        if (!has_next) break;
#pragma unroll
        for (int a = 0; a < 2; ++a)
#pragma unroll
            for (int b = 0; b < 2; ++b)
#pragma unroll
                for (int m = 0; m < 4; ++m)
#pragma unroll
                    for (int n = 0; n < 2; ++n) acc[a][b][m][n] = (f32x4){0.f, 0.f, 0.f, 0.f};
        cur = nxt; cA = nA; cB = nB; ++ui;
    }
    PG8_WAIT_V(0);
    if (wr == 0) PG8_BAR;
    PG8_BAR;
#undef PG8_SA
#undef PG8_SB
#undef PG8_STAGE
#undef PG8_LDA
#undef PG8_LDB
#undef PG8_MMA
#undef PG8_LD16
#undef PG8_WAIT_V
#undef PG8_WAIT_L
#undef PG8_BAR
#undef PG8_SCHED
}
}

#define XB_TMO      128
#define XB_XCNT(j)  (256  + 64 * (j))
#define XB_XSUB(j)  (1280 + 64 * (j))
#define XB_XGEN(j)  (2304 + 64 * (j))
#define XB_TOP      3328
#define XB_TOPGEN   3392
#define XCD_BAR_WORDS 3456
#define XB_SPIN_CAP (1u << 20)
#define LAS __attribute__((address_space(3)))
__device__ __forceinline__ unsigned xb_ld(unsigned* p)              { return __hip_atomic_load(p, __ATOMIC_RELAXED, __HIP_MEMORY_SCOPE_AGENT); }
__device__ __forceinline__ unsigned xb_add(unsigned* p, unsigned v) { return __hip_atomic_fetch_add(p, v, __ATOMIC_RELAXED, __HIP_MEMORY_SCOPE_AGENT); }
__device__ __forceinline__ unsigned xb_xcc_id() { return (unsigned)__builtin_amdgcn_s_getreg((3 << 11) | 20) & 0xFu; }
#define XB_SPIN(cond, bar) do { unsigned _sp = 0; while (cond) { __builtin_amdgcn_s_sleep(1); \
    if ((++_sp & 255u) == 0u) { if (xb_ld(&(bar)[XB_TMO])) break; if (_sp > XB_SPIN_CAP) { atomicAdd(&(bar)[XB_TMO], 1u); break; } } } } while (0)
struct XcdBarrier { unsigned* bar; unsigned x; volatile LAS unsigned* st; };
__device__ __forceinline__ XcdBarrier xcd_barrier_post(unsigned* bar, volatile LAS unsigned* st) {
    XcdBarrier b; b.bar = bar; b.x = xb_xcc_id(); b.st = st;
    if (threadIdx.x == 0) (void)xb_add(&bar[XB_XCNT(b.x)], 1u);
    return b;
}
__device__ __forceinline__ void xcd_barrier_complete(unsigned* bar, unsigned x, unsigned& nloc, unsigned& nx) {
    const unsigned G = gridDim.x * gridDim.y * gridDim.z;
    unsigned sum, cnt, mine, sp = 0u;
    for (;;) {
        sum = 0u; cnt = 0u; mine = 0u;
#pragma unroll
        for (unsigned j = 0; j < 16; ++j) { const unsigned c = xb_ld(&bar[XB_XCNT(j)]); sum += c; cnt += (c > 0u) ? 1u : 0u; mine = (j == x) ? c : mine; }
        if (sum == G) break;
        __builtin_amdgcn_s_sleep(1);
        if ((++sp & 255u) == 0u) { if (xb_ld(&bar[XB_TMO])) break; if (sp > XB_SPIN_CAP) { atomicAdd(&bar[XB_TMO], 1u); break; } }
    }
    nloc = mine > 0u ? mine : 1u; nx = cnt > 0u ? cnt : 1u;
}
__device__ __forceinline__ void xcd_barrier(const XcdBarrier& b) {
    asm volatile("s_waitcnt vmcnt(0)" ::: "memory");
    __syncthreads();
    if (threadIdx.x == 0) {
        unsigned* bar = b.bar;
        __builtin_amdgcn_s_waitcnt(0);
        unsigned nloc = b.st[0], nx = b.st[1];
        if (nloc == 0u) { xcd_barrier_complete(bar, b.x, nloc, nx); b.st[0] = nloc; b.st[1] = nx; }
        const unsigned old = xb_add(&bar[XB_XSUB(b.x)], 1u);
        const unsigned gen = old / nloc;
        if (old + 1u == (gen + 1u) * nloc) {
            __builtin_amdgcn_fence(__ATOMIC_RELEASE, "agent");
            asm volatile("s_waitcnt vmcnt(0)" ::: "memory");
            const unsigned og = xb_add(&bar[XB_TOP], 1u);
            const unsigned tg = og / nx;
            if (og + 1u == (tg + 1u) * nx) xb_add(&bar[XB_TOPGEN], 1u);
            else XB_SPIN(xb_ld(&bar[XB_TOPGEN]) == tg, bar);
            __builtin_amdgcn_fence(__ATOMIC_ACQUIRE, "agent");
            xb_add(&bar[XB_XGEN(b.x)], 1u);
            asm volatile("s_waitcnt vmcnt(0)" ::: "memory");
        } else {
            XB_SPIN(xb_ld(&bar[XB_XGEN(b.x)]) == gen, bar);
            __builtin_amdgcn_fence(__ATOMIC_ACQUIRE, "agent");
            asm volatile("s_waitcnt vmcnt(0)" ::: "memory");
        }
    }
    __syncthreads();
}

template <bool XI16, bool XO16, bool HN8, bool R2E = false>
__device__ __forceinline__ void resnorm_rows(const void* xi_, const bf16_t* __restrict__ t, const float* __restrict__ part, const float* __restrict__ gpost, const float* __restrict__ gpre, void* xo_, bf16_t* hn, int bid, int nb, float* r2out = nullptr) {
    const int wid = threadIdx.x >> 6, lane = threadIdx.x & 63;
    for (int row = bid * 8 + wid; row < S; row += nb * 8) {
        const float ss = wave_sum(part[(size_t)row * 64 + lane]); const float r = rsqrtf(ss * (1.0f / DM) + EPS);
        float s2 = 0.f;
#pragma unroll 1
        for (int i0 = 0; i0 < 16; i0 += 8) {
            f32x4 xv[8]; u32x2 tw[8];
#pragma unroll
            for (int j = 0; j < 8; ++j) { const size_t e = (size_t)row * DM + (i0 + j) * 256 + lane * 4;
                if (XI16) { const u32x2 xw = *(const u32x2*)((const bf16_t*)xi_ + e); xv[j][0] = __uint_as_float(xw.x << 16); xv[j][1] = __uint_as_float(xw.x & 0xffff0000u); xv[j][2] = __uint_as_float(xw.y << 16); xv[j][3] = __uint_as_float(xw.y & 0xffff0000u); }
                else xv[j] = *(const f32x4*)((const float*)xi_ + e);
                tw[j] = *(const u32x2*)(t + e); }
#pragma unroll
            for (int j = 0; j < 8; ++j) { const int col = (i0 + j) * 256 + lane * 4; const size_t e = (size_t)row * DM + col; const f32x4 gg = *(const f32x4*)(gpost + col);
                f32x4 o; o[0] = xv[j][0] + __uint_as_float(tw[j].x << 16) * r * gg[0]; o[1] = xv[j][1] + __uint_as_float(tw[j].x & 0xffff0000u) * r * gg[1];
                o[2] = xv[j][2] + __uint_as_float(tw[j].y << 16) * r * gg[2]; o[3] = xv[j][3] + __uint_as_float(tw[j].y & 0xffff0000u) * r * gg[3];
                s2 += o[0] * o[0] + o[1] * o[1] + o[2] * o[2] + o[3] * o[3];
                if (XO16) { u32x2 w; w.x = pk2(o[0], o[1]); w.y = pk2(o[2], o[3]); *(u32x2*)((bf16_t*)xo_ + e) = w; } else *(f32x4*)((float*)xo_ + e) = o;
                if (R2E) { const f32x4 gp = *(const f32x4*)(gpre + col); *(unsigned*)((unsigned char*)hn + (size_t)row * LD8 + col) = pk4_fp8(o[0] * gp[0], o[1] * gp[1], o[2] * gp[2], o[3] * gp[3]); } }
        }
        if (R2E) { s2 = wave_sum(s2); if (lane == 0) r2out[row] = rsqrtf(s2 * (1.0f / DM) + EPS); continue; }
        if (hn) { s2 = wave_sum(s2); const float r2 = rsqrtf(s2 * (1.0f / DM) + EPS);
#pragma unroll 1
            for (int i0 = 0; i0 < 16; i0 += 8) {
                f32x4 v[8];
#pragma unroll
                for (int j = 0; j < 8; ++j) { const size_t e = (size_t)row * DM + (i0 + j) * 256 + lane * 4;
                    if (XO16) { const u32x2 xw = *(const u32x2*)((const bf16_t*)xo_ + e); v[j][0] = __uint_as_float(xw.x << 16); v[j][1] = __uint_as_float(xw.x & 0xffff0000u); v[j][2] = __uint_as_float(xw.y << 16); v[j][3] = __uint_as_float(xw.y & 0xffff0000u); }
                    else v[j] = *(const f32x4*)((const float*)xo_ + e); }
#pragma unroll
                for (int j = 0; j < 8; ++j) { const int col = (i0 + j) * 256 + lane * 4; const f32x4 gg = *(const f32x4*)(gpre + col);
                    if (HN8) *(unsigned*)((unsigned char*)hn + (size_t)row * LD8 + col) = pk4_fp8(v[j][0] * r2 * gg[0], v[j][1] * r2 * gg[1], v[j][2] * r2 * gg[2], v[j][3] * r2 * gg[3]);
                    else { u32x2 w; w.x = pk2(v[j][0] * r2 * gg[0], v[j][1] * r2 * gg[1]); w.y = pk2(v[j][2] * r2 * gg[2], v[j][3] * r2 * gg[3]); *(u32x2*)(hn + (size_t)row * LDK + col) = w; } }
            } }
    }
}

namespace at {
typedef short s16x4 __attribute__((ext_vector_type(4)));
typedef float f32x16 __attribute__((ext_vector_type(16)));
constexpr int SHM_T = 64 * 128 * 2;
constexpr int OFF_V = 0, OFF_K = 3 * SHM_T, OFF_WS = 6 * SHM_T;
constexpr int OFF_IMP = OFF_WS + 2048, IMP_LD = 129, OFF_SEL = OFF_IMP + 64 * IMP_LD * 4, OFF_END = OFF_SEL + 1024;
static_assert(OFF_END <= 136 * 1024, "attention LDS");
constexpr float THR = 8.f;
constexpr float C2 = 1.4426950408889634f * QSCALE;
constexpr unsigned WHUGE = 0x7fffffffu;
#define KSWZ(row, colB) ((row) * 256 + ((colB) ^ (((row) & 7) << 4)))
#define SBAR() __builtin_amdgcn_sched_barrier(0)
__device__ __forceinline__ int v_st(int k, int c) { const int kk = (k & ~0xC) | ((k & 4) << 1) | ((k & 8) >> 1); return ((kk >> 3) * 4 + (c >> 5)) * 512 + ((kk & 7) * 32 + (c & 31)) * 2; }
__device__ __forceinline__ int v_rd_base(int lane) { return ((lane & 3) << 3) | (((lane >> 2) & 3) << 6) | (((lane >> 4) & 1) << 5) | (((lane >> 5) & 1) << 8); }
constexpr int v_rd_off(int d0, int ks, int half) { return d0 * 512 + ks * 4096 + half * 2048; }
__device__ __forceinline__ int crow(int r, int hi) { return (r & 3) + 8 * (r >> 2) + 4 * hi; }
__device__ __forceinline__ unsigned cvtpk(float lo, float hi) { unsigned r; asm volatile("v_cvt_pk_bf16_f32 %0, %1, %2" : "=v"(r) : "v"(lo), "v"(hi)); return r; }
__device__ __forceinline__ void mask_tile(f32x16& p0, f32x16& p1, int dq, unsigned W) {
    const float NEG = -__builtin_inff();
#pragma unroll
    for (int r = 0; r < 16; ++r) { const int c = (r & 3) + 8 * (r >> 2); if ((unsigned)(dq - c) >= W) p0[r] = NEG; if ((unsigned)(dq - c - 32) >= W) p1[r] = NEG; }
}
__device__ __forceinline__ void partialSM(f32x16& p0, f32x16& p1, float& m_reg, float& alpha, bool rowok) {
    float pmax = p0[0];
#pragma unroll
    for (int r = 1; r < 16; ++r) pmax = fmaxf(pmax, p0[r]);
#pragma unroll
    for (int r = 0; r < 16; ++r) pmax = fmaxf(pmax, p1[r]);
    { auto rr = __builtin_amdgcn_permlane32_swap(__float_as_uint(pmax), __float_as_uint(pmax), false, false); pmax = fmaxf(__uint_as_float(rr[0]), __uint_as_float(rr[1])); }
    pmax = rowok ? pmax : -__builtin_inff();
    float mn;
    if (__builtin_expect(__all((pmax - m_reg) * QSCALE <= THR), 1)) { mn = m_reg; alpha = 1.f; }
    else { mn = fmaxf(m_reg, pmax); alpha = __builtin_amdgcn_exp2f((m_reg - mn) * C2); m_reg = mn; }
    const float mnL = rowok ? -mn * C2 : -__builtin_inff();
#pragma unroll
    for (int r = 0; r < 16; ++r) { p0[r] = __builtin_amdgcn_exp2f(fmaf(p0[r], C2, mnL)); p1[r] = __builtin_amdgcn_exp2f(fmaf(p1[r], C2, mnL)); }
}
__device__ __forceinline__ void packP(const f32x16& p0, const f32x16& p1, bf16x8& pa0, bf16x8& pa1, bf16x8& pa2, bf16x8& pa3) {
#define PK4(P, B_, OUT) do { unsigned a0 = cvtpk(P[B_+0], P[B_+1]), a1 = cvtpk(P[B_+2], P[B_+3]); unsigned b0 = cvtpk(P[B_+4], P[B_+5]), b1 = cvtpk(P[B_+6], P[B_+7]); \
        auto r0 = __builtin_amdgcn_permlane32_swap(a0, b0, false, false); auto r1 = __builtin_amdgcn_permlane32_swap(a1, b1, false, false); \
        u32x4 w = {r0[0], r1[0], r0[1], r1[1]}; OUT = *reinterpret_cast<bf16x8*>(&w); } while (0)
    PK4(p0, 0, pa0); PK4(p0, 8, pa1); PK4(p1, 0, pa2); PK4(p1, 8, pa3);
#undef PK4
}
__device__ __forceinline__ float rowsum(const f32x16& p0, const f32x16& p1) {
    float ps = 0.f;
#pragma unroll
    for (int r = 0; r < 16; ++r) ps += p0[r] + p1[r];
    auto rr = __builtin_amdgcn_permlane32_swap(__float_as_uint(ps), __float_as_uint(ps), false, false); return __uint_as_float(rr[0]) + __uint_as_float(rr[1]);
}
__device__ __forceinline__ void qkt(f32x16& p0, f32x16& p1, PG8_LAS const unsigned char* lds, int kboff, int r32, int hi, const bf16x8 (&qr)[8], bool act) {
    if (!act) { const float NEG = -__builtin_inff();
#pragma unroll
        for (int r = 0; r < 16; ++r) { p0[r] = NEG; p1[r] = NEG; } return; }
    const f32x16 z = {0.f, 0.f, 0.f, 0.f, 0.f, 0.f, 0.f, 0.f, 0.f, 0.f, 0.f, 0.f, 0.f, 0.f, 0.f, 0.f};
    const int kb_ = (int)(uintptr_t)lds + kboff;
    const int a0 = kb_ + KSWZ(r32, (0 * 16 + hi * 8) * 2), a1 = kb_ + KSWZ(r32, (1 * 16 + hi * 8) * 2), a2 = kb_ + KSWZ(r32, (2 * 16 + hi * 8) * 2), a3 = kb_ + KSWZ(r32, (3 * 16 + hi * 8) * 2);
#define KRD(dst, addr, off) asm volatile("ds_read_b128 %0, %1 offset:%2" : "=&v"(dst) : "v"(addr), "i"(OFF_K + (off)) : "memory")
#define KWAIT(n) do { asm volatile("s_waitcnt lgkmcnt(" #n ")" ::: "memory"); SBAR(); } while (0)
#define KMM(x0, x1, d0) do { p0 = __builtin_amdgcn_mfma_f32_32x32x16_bf16(x0, qr[d0], p0, 0, 0, 0); p1 = __builtin_amdgcn_mfma_f32_32x32x16_bf16(x1, qr[d0], p1, 0, 0, 0); } while (0)
    bf16x8 k0, k1, k2, k3, k4, k5, k6, k7;
    KRD(k0, a0, 0); KRD(k1, a0, 8192); KRD(k2, a1, 0); KRD(k3, a1, 8192); KRD(k4, a2, 0); KRD(k5, a2, 8192); KRD(k6, a3, 0); KRD(k7, a3, 8192);
    KWAIT(6); p0 = __builtin_amdgcn_mfma_f32_32x32x16_bf16(k0, qr[0], z, 0, 0, 0); p1 = __builtin_amdgcn_mfma_f32_32x32x16_bf16(k1, qr[0], z, 0, 0, 0); SBAR(); KRD(k0, a0, 128); KRD(k1, a0, 128 + 8192);
    KWAIT(6); KMM(k2, k3, 1); SBAR(); KRD(k2, a1, 128); KRD(k3, a1, 128 + 8192);
    KWAIT(6); KMM(k4, k5, 2); SBAR(); KRD(k4, a2, 128); KRD(k5, a2, 128 + 8192);
    KWAIT(6); KMM(k6, k7, 3); SBAR(); KRD(k6, a3, 128); KRD(k7, a3, 128 + 8192);
    KWAIT(6); KMM(k0, k1, 4);
    KWAIT(4); KMM(k2, k3, 5);
    KWAIT(2); KMM(k4, k5, 6);
    KWAIT(0); KMM(k6, k7, 7);
#undef KMM
#undef KWAIT
#undef KRD
}
__device__ __forceinline__ void pv_tile(f32x16 (&o)[4], int vb0  , bf16x8 pa0, bf16x8 pa1, bf16x8 pa2, bf16x8 pa3, bool act) {
    if (!act) return;
#define TRRD(dst, off) asm volatile("ds_read_b64_tr_b16 %0, %1 offset:%2" : "=&v"(dst) : "v"(vb0), "i"(off) : "memory")
#define PV_D0(d0) do { s16x4 l0, l1, l2, l3, h0, h1, h2, h3; constexpr int b_ = v_rd_off(d0, 0, 0); \
        TRRD(l0, b_); TRRD(h0, b_ + 2048); TRRD(l1, b_ + 4096); TRRD(h1, b_ + 6144); TRRD(l2, b_ + 8192); TRRD(h2, b_ + 10240); TRRD(l3, b_ + 12288); TRRD(h3, b_ + 14336); \
        asm volatile("s_waitcnt lgkmcnt(0)" ::: "memory"); SBAR(); \
        o[d0] = __builtin_amdgcn_mfma_f32_32x32x16_bf16(pa0, (bf16x8){l0[0], l0[1], l0[2], l0[3], h0[0], h0[1], h0[2], h0[3]}, o[d0], 0, 0, 0); \
        o[d0] = __builtin_amdgcn_mfma_f32_32x32x16_bf16(pa1, (bf16x8){l1[0], l1[1], l1[2], l1[3], h1[0], h1[1], h1[2], h1[3]}, o[d0], 0, 0, 0); \
        o[d0] = __builtin_amdgcn_mfma_f32_32x32x16_bf16(pa2, (bf16x8){l2[0], l2[1], l2[2], l2[3], h2[0], h2[1], h2[2], h2[3]}, o[d0], 0, 0, 0); \
        o[d0] = __builtin_amdgcn_mfma_f32_32x32x16_bf16(pa3, (bf16x8){l3[0], l3[1], l3[2], l3[3], h3[0], h3[1], h3[2], h3[3]}, o[d0], 0, 0, 0); } while (0)
    PV_D0(0); PV_D0(1); PV_D0(2); PV_D0(3);
#undef PV_D0
#undef TRRD
}

__device__ __forceinline__ void lds_add(PG8_LAS unsigned* p, unsigned v) { (void)__hip_atomic_fetch_add(p, v, __ATOMIC_RELAXED, __HIP_MEMORY_SCOPE_WORKGROUP); }
struct KV { const bf16_t* K; const bf16_t* V; int ks, vs; };
struct PolWin {
    int qmin, qmax, Wn;
    __device__ __forceinline__ void tile(int, int kb, unsigned& W, bool& act, bool& need, bool& rowok) const {
        rowok = true; W = (unsigned)Wn; act = (kb <= qmax) && (kb + 63 >= qmin - Wn + 1); need = !((kb + 63 <= qmin) && (kb >= qmax - Wn + 1)); }
};
struct PolCmp {
    int lmin, lmax;
    __device__ __forceinline__ void tile(int, int kb, unsigned& W, bool& act, bool& need, bool& rowok) const { rowok = true; W = WHUGE; act = kb <= lmax; need = kb + 63 > lmin; }
};
struct PolSel {
    PG8_LAS const unsigned* selrow; int cur;
    __device__ __forceinline__ void tile(int t, int, unsigned& W, bool& act, bool& need, bool& rowok) const {
        const bool bit = (selrow[t >> 5] >> (t & 31)) & 1u; rowok = bit; W = WHUGE; act = __ballot(bit) != 0ull; need = (t == cur); }
};

struct BgNone {
    __device__ __forceinline__ bool want() const { return false; }
    __device__ __forceinline__ bool pending() const { return false; }
    __device__ __forceinline__ void issue(int) {}
    __device__ __forceinline__ void commit(int) {}
};
struct BgConvGU {
    const float* W0; unsigned char* Bt0; const float* W1; unsigned char* Bt1; const float* W2; const float* W3; unsigned char* Bt2; PG8_LAS unsigned char* wl; int gw, n_total, si; bool pend;
    static constexpr int TK0 = DM / 64, TK1 = (DFF / 2) / 64, TK2 = 512 / 64, TK3 = 2048 / 64;
    static constexpr int B1 = (NGU / 64) * TK0, B2 = B1 + (DM / 64) * TK1, B3 = B2 + (DM / 64) * TK2, B4 = B3 + (DM / 64) * TK3;
    struct Sl { const float* W; unsigned char* dst; size_t ldw; int n0; bool f8, gu; };
    __device__ __forceinline__ void init(const float* w_gu, unsigned char* gut, const float* w_down, unsigned char* wdt, const float* w_a, const float* w_b, unsigned char* wabt,
                                         PG8_LAS unsigned char* wl_, int gw_, bool on) {
        W0 = w_gu; Bt0 = gut; W1 = w_down; Bt1 = wdt; W2 = w_a; W3 = w_b; Bt2 = wabt; wl = wl_; gw = gw_; si = 0; pend = false;
        n_total = (on && gw_ < B4) ? 4 * ((B4 - gw_ + 2047) / 2048) : 0; }
    __device__ __forceinline__ bool want() const { return !pend && si < n_total; }
    __device__ __forceinline__ bool pending() const { return pend; }
#define BG_LOC(Ip, TK) const int nn_ = (((Ip) / (4 * (TK))) * 4 + ((Ip) & 3)) * 64, kk_ = (((Ip) >> 2) % (TK)) * 64 + 16 * (si & 3)
    __device__ __forceinline__ void decode(int lane_n, Sl& r, const float*& src) const {
        const int I = gw + (si >> 2) * 2048;
        if (I < B1) { BG_LOC(I, TK0); r = Sl{W0, Bt0 + (size_t)nn_ * LD8 + kk_, (size_t)NGU, nn_, true, true}; src = W0 + (size_t)kk_ * NGU + MapGU()(nn_ + lane_n); }
        else if (I < B2) { BG_LOC(I - B1, TK1); r = Sl{W1, Bt1 + (size_t)nn_ * LDA8 + kk_, (size_t)DM, nn_, true, false}; src = W1 + (size_t)kk_ * DM + nn_ + lane_n; }
        else if (I < B3) { BG_LOC(I - B2, TK2); r = Sl{W2, Bt2 + ((size_t)nn_ * KAB + kk_) * 2, (size_t)DM, nn_, false, false}; src = W2 + (size_t)kk_ * DM + nn_ + lane_n; }
        else { BG_LOC(I - B3, TK3); r = Sl{W3, Bt2 + ((size_t)nn_ * KAB + 512 + kk_) * 2, (size_t)DM, nn_, false, false}; src = W3 + (size_t)kk_ * DM + nn_ + lane_n; }
    }
#undef BG_LOC
    __device__ __forceinline__ void issue(int lane) {
        Sl r; const float* p; decode(4 * (lane & 15), r, p); p += (size_t)(lane >> 4) * r.ldw;
        const __amdgpu_buffer_rsrc_t rs = __builtin_amdgcn_make_buffer_rsrc((void*)r.W, 0, 0x7fffffff, 0x00020000);
        const int vo = (int)((const char*)p - (const char*)r.W), rstep = (int)r.ldw * 16;
#pragma unroll
        for (int i = 0; i < 4; ++i) __builtin_amdgcn_raw_ptr_buffer_load_lds(rs, (PG8_LAS unsigned*)(wl + i * 1024), 16, vo, i * rstep, 0, 2);
        pend = true;
    }
    __device__ __forceinline__ void commit(int lane) {
        float v[16];
#pragma unroll
        for (int kk = 0; kk < 16; ++kk) v[kk] = *(PG8_LAS const float*)(wl + kk * 256 + lane * 4);
        Sl r; const float* p; decode(0, r, p);
        if (r.f8) {
#pragma unroll
            for (int kk = 0; kk < 16; ++kk) v[kk] *= W8SCALE;
            u32x4 w; w.x = pk4_fp8(v[0], v[1], v[2], v[3]); w.y = pk4_fp8(v[4], v[5], v[6], v[7]); w.z = pk4_fp8(v[8], v[9], v[10], v[11]); w.w = pk4_fp8(v[12], v[13], v[14], v[15]);
            *(u32x4*)(r.dst + (size_t)lane * (r.gu ? LD8 : LDA8)) = w;
        } else {
            u32x4 w0, w1; w0.x = pk2(v[0], v[1]); w0.y = pk2(v[2], v[3]); w0.z = pk2(v[4], v[5]); w0.w = pk2(v[6], v[7]); w1.x = pk2(v[8], v[9]); w1.y = pk2(v[10], v[11]); w1.z = pk2(v[12], v[13]); w1.w = pk2(v[14], v[15]);
            unsigned char* d = r.dst + (size_t)lane * (KAB * 2); *(u32x4*)d = w0; *(u32x4*)(d + 16) = w1;
        }
        ++si; pend = false;
    }
};

template <int MODE, class Pol, class BG>
__device__ __forceinline__ void flash_loop(const Pol& pol, PG8_LAS unsigned char* lds, const KV kv, int j_lo, int nt, const bf16x8 (&qr)[8], int dq_base,
                                           f32x16 (&o)[4], float& m_reg, float& l_reg, float inv_l, PG8_LAS unsigned* improw, BG& bg) {
    int tid = threadIdx.x; asm volatile("" : "+v"(tid));
    const int wid = __builtin_amdgcn_readfirstlane(tid >> 6), lane = tid & 63, r32 = lane & 31, hi = lane >> 5;
    PG8_LAS float* al_l = (PG8_LAS float*)(lds + OFF_WS) + wid * 64 + 32;
    const int vb0 = (int)(uintptr_t)(lds + OFF_V) + v_rd_base(lane);
    unsigned offK[2], offV[2];
#pragma unroll
    for (int i = 0; i < 2; ++i) { const int b = tid * 16 + i * 8192;
        { const int row = b >> 8, colB = (b & 255) ^ ((row & 7) << 4); offK[i] = (unsigned)(row * kv.ks + (colB >> 1)) * 2u; }
        { const int sub = b >> 9, w = (b & 511) >> 1, kk = (sub >> 2) * 8 + (w >> 5), cc = (sub & 3) * 32 + (w & 31), k = (kk & ~0xC) | ((kk & 4) << 1) | ((kk & 8) >> 1); offV[i] = (unsigned)(k * kv.vs + cc) * 2u; } }
    const unsigned ldsw = (unsigned)wid * 1024u;
#define SLOAD(t_) SLOAD2(t_, t_)
    const __amdgpu_buffer_rsrc_t rsK = __builtin_amdgcn_make_buffer_rsrc((void*)kv.K, 0, 0x7fffffff, 0x00020000), rsV = __builtin_amdgcn_make_buffer_rsrc((void*)kv.V, 0, 0x7fffffff, 0x00020000);
#define SLOAD2(t_, sl_) do { const int so_k__ = (j_lo + (t_)) * 64 * kv.ks * 2, so_v__ = (j_lo + (t_)) * 64 * kv.vs * 2; \
        const int bo__ = (sl_) * SHM_T; \
        _Pragma("unroll") for (int i_ = 0; i_ < 2; ++i_) { \
            __builtin_amdgcn_raw_ptr_buffer_load_lds(rsK, (PG8_LAS unsigned*)(lds + OFF_K + bo__ + ldsw + i_ * 8192), 16, (int)offK[i_], so_k__, 0, 0); \
            if (MODE != 1) __builtin_amdgcn_raw_ptr_buffer_load_lds(rsV, (PG8_LAS unsigned*)(lds + OFF_V + bo__ + ldsw + i_ * 8192), 16, (int)offV[i_], so_v__, 0, 0); } } while (0)
#define WAIT_BUT_ONE() do { if (MODE == 1) asm volatile("s_waitcnt vmcnt(2)" ::: "memory"); else asm volatile("s_waitcnt vmcnt(4)" ::: "memory"); } while (0)
#define RAW_BAR() do { if (MODE != 2) { SBAR(); asm volatile("s_waitcnt lgkmcnt(0)" ::: "memory"); __builtin_amdgcn_s_barrier(); asm volatile("" ::: "memory"); SBAR(); } else __syncthreads(); } while (0)
    bf16x8 pa0, pa1, pa2, pa3;
    if (wid >= 4) __builtin_amdgcn_s_setprio(1);
    __syncthreads();
    SLOAD(0);
    if (nt > 1) { SLOAD(1); WAIT_BUT_ONE(); } else asm volatile("s_waitcnt vmcnt(0)" ::: "memory");
    RAW_BAR();
    int slot = 0;
    for (int t = 0; t < nt; ++t) {
        const int kb_ = (j_lo + t) * 64; unsigned W_; bool act_, need_, rowok_; pol.tile(t, kb_, W_, act_, need_, rowok_);
        if (t + 2 < nt) SLOAD2(t + 2, slot == 0 ? 2 : slot - 1);
        const bool bgi = bg.want(); if (bgi) bg.issue(lane);
        SBAR();
        if (MODE == 2 || act_) {
        f32x16 p0, p1; qkt(p0, p1, lds, slot * SHM_T, r32, hi, qr, act_);
        if (act_ && need_) mask_tile(p0, p1, dq_base - kb_, W_);
        if (MODE == 2) { const float mnL = -m_reg * C2;
#pragma unroll
            for (int r = 0; r < 16; ++r) { p0[r] = __builtin_amdgcn_exp2f(fmaf(p0[r], C2, mnL)) * inv_l; p1[r] = __builtin_amdgcn_exp2f(fmaf(p1[r], C2, mnL)) * inv_l; }
            if (act_) {
#pragma unroll
                for (int q4 = 0; q4 < 4; ++q4) { const int mblk = (kb_ >> 2) + 2 * q4 + hi;
                    float vm0 = p0[4 * q4] + p0[4 * q4 + 1] + p0[4 * q4 + 2] + 0.5f * p0[4 * q4 + 3], vn0 = 0.5f * p0[4 * q4 + 3];
                    float vm1 = p1[4 * q4] + p1[4 * q4 + 1] + p1[4 * q4 + 2] + 0.5f * p1[4 * q4 + 3], vn1 = 0.5f * p1[4 * q4 + 3];
                    vm0 += __shfl_xor(vm0, 1); vn0 += __shfl_xor(vn0, 1); vm1 += __shfl_xor(vm1, 1); vn1 += __shfl_xor(vn1, 1);
                    vm0 += __shfl_xor(vm0, 2); vn0 += __shfl_xor(vn0, 2); vm1 += __shfl_xor(vm1, 2); vn1 += __shfl_xor(vn1, 2);
                    if ((r32 & 3) == 0) {
                        lds_add(improw + mblk, (unsigned)(vm0 * 268435456.0f + 0.5f)); if (mblk + 1 < 128) lds_add(improw + mblk + 1, (unsigned)(vn0 * 268435456.0f + 0.5f));
                        lds_add(improw + mblk + 8, (unsigned)(vm1 * 268435456.0f + 0.5f)); if (mblk + 9 < 128) lds_add(improw + mblk + 9, (unsigned)(vn1 * 268435456.0f + 0.5f)); } } }
            packP(p0, p1, pa0, pa1, pa2, pa3);
        } else { float alpha; partialSM(p0, p1, m_reg, alpha, rowok_); l_reg = l_reg * alpha + rowsum(p0, p1);
            if (MODE == 0) { if (__any(alpha < 1.f)) { if (hi == 0) al_l[r32] = alpha; asm volatile("s_waitcnt lgkmcnt(0)" ::: "memory");
#pragma unroll
                    for (int d_ = 0; d_ < 4; ++d_)
#pragma unroll
                        for (int r = 0; r < 16; ++r) o[d_][r] *= al_l[crow(r, hi)]; }
                packP(p0, p1, pa0, pa1, pa2, pa3); } }
        if (MODE != 1) { SBAR(); pv_tile(o, vb0 + slot * SHM_T, pa0, pa1, pa2, pa3, act_); }
        }
        if (t + 2 < nt) { if (bgi) asm volatile("s_waitcnt vmcnt(8)" ::: "memory"); else WAIT_BUT_ONE(); } else { if (bgi) asm volatile("s_waitcnt vmcnt(4)" ::: "memory"); else asm volatile("s_waitcnt vmcnt(0)" ::: "memory"); }
        if (!bgi && bg.pending()) { SBAR(); bg.commit(lane); }
        RAW_BAR(); slot = slot == 2 ? 0 : slot + 1;
    }
    if (bg.pending()) { asm volatile("s_waitcnt vmcnt(0)" ::: "memory"); bg.commit(lane); }
    if (wid >= 4) __builtin_amdgcn_s_setprio(0);
#undef WAIT_BUT_ONE
#undef RAW_BAR
#undef SLOAD
#undef SLOAD2
}

template <bool ACCUM, class RowPtr>
__device__ __forceinline__ void store_o(PG8_LAS unsigned char* lds, const f32x16 (&o)[4], float f_row, const RowPtr& rp) {
    int tid = threadIdx.x; asm volatile("" : "+v"(tid));
    const int wid = __builtin_amdgcn_readfirstlane(tid >> 6), lane = tid & 63, r32 = lane & 31, hi = lane >> 5, odd = r32 & 1;
    PG8_LAS float* li_l = (PG8_LAS float*)(lds + OFF_WS) + wid * 64;
    if (hi == 0) li_l[r32] = f_row; asm volatile("s_waitcnt lgkmcnt(0)" ::: "memory");
    constexpr int RS = 272;
    PG8_LAS unsigned char* st = lds + OFF_V + wid * (32 * RS);
#pragma unroll
    for (int k = 0; k < 8; ++k) { const float f0 = li_l[crow(2 * k, hi)], f1 = li_l[crow(2 * k + 1, hi)]; const int row = crow(2 * k + odd, hi);
#pragma unroll
        for (int d0 = 0; d0 < 4; ++d0) { const float v0 = o[d0][2 * k] * f0, v1 = o[d0][2 * k + 1] * f1;
            const float rc = __shfl_xor(odd ? v0 : v1, 1);
            const float a = odd ? rc : v0, b = odd ? v1 : rc;
            *(PG8_LAS unsigned*)(st + row * RS + (d0 * 32 + (r32 & ~1)) * 2) = cvtpk(a, b); } }
    asm volatile("s_waitcnt lgkmcnt(0)" ::: "memory");
    bf16_t* gp[8]; u32x4 old[8];
#pragma unroll
    for (int i = 0; i < 8; ++i) { const int id = i * 64 + lane; gp[i] = rp(id >> 4) + (id & 15) * 8; if (ACCUM) old[i] = *(const u32x4*)gp[i]; }
#pragma unroll
    for (int i = 0; i < 8; ++i) { const int id = i * 64 + lane; u32x4 w = *(PG8_LAS const u32x4*)(st + (id >> 4) * RS + (id & 15) * 16);
        if (ACCUM) { float x[8], y[8]; unpack8(w, x); unpack8(old[i], y);
#pragma unroll
            for (int j = 0; j < 8; ++j) x[j] += y[j];
            w = pack8(x); }
        *(u32x4*)gp[i] = w; }
}
}

constexpr size_t WS_ODIL = WS_MG;
constexpr size_t WS_LDIL = WS_MX;
__device__ __forceinline__ void dilated_unit(const Ctx& c, PG8_LAS unsigned char* lds, int u) {
    using namespace at;
    const int tid = threadIdx.x, wid = __builtin_amdgcn_readfirstlane(tid >> 6), lane = tid & 63, r32 = lane & 31, hi = lane >> 5;
    const int g = u >> 7, v = u & 127, h = v & 3, w = v >> 2;
    const int rate = g == 0 ? 1 : (g == 1 ? 4 : 16), nblk = (S / rate) / 256, cls = w / nblk, blk = w % nblk;
    const int I0 = blk * 256, qmin = I0 + wid * 32, qi = qmin + r32;
    const size_t colo = (size_t)g * 512 + h * 128;
    const bf16_t* Q = WSP(bf16_t, WS_QA) + (size_t)(cls + rate * qi) * 1536 + colo;
    bf16x8 qr[8];
#pragma unroll
    for (int d0 = 0; d0 < 8; ++d0) qr[d0] = *(const bf16x8*)(Q + d0 * 16 + hi * 8);
    KV kv{WSP(bf16_t, WS_KA) + (size_t)cls * 1536 + colo, WSP(bf16_t, WS_VA) + (size_t)cls * 1536 + colo, rate * 1536, rate * 1536};
    const int j_lo = (I0 - 128 > 0 ? I0 - 128 : 0) / 64, nt = (I0 + 255) / 64 + 1 - j_lo;
    f32x16 o[4];
#pragma unroll
    for (int d = 0; d < 4; ++d)
#pragma unroll
        for (int r = 0; r < 16; ++r) o[d][r] = 0.f;
    float m_reg = -1e30f, l_reg = 0.f;
    PolWin pol{qmin, qmin + 31, 129};
    BgNone nobg; flash_loop<0>(pol, lds, kv, j_lo, nt, qr, qi - 4 * hi, o, m_reg, l_reg, 0.f, nullptr, nobg);
    bf16_t* od = WSP(bf16_t, WS_ODIL) + (size_t)g * S * 512 + h * 128;
    const int p0 = cls + rate * qmin;
    store_o<false>(lds, o, 1.0f / l_reg, [&](int orow) { return od + (size_t)(p0 + rate * orow) * 512; });
    if (hi == 0) WSP(float, WS_LDIL)[((size_t)g * S + (cls + rate * qi)) * 4 + h] = m_reg * QSCALE + __logf(l_reg);
}
__device__ __forceinline__ void dilated_combine(const Ctx& c, int bid, int nb) {
    const int tid = threadIdx.x, stride = nb * 512;
    for (int i0 = bid * 512 + tid; i0 < S * 64; i0 += 4 * stride) {
        float l0[4], l1[4], l2[4]; u32x4 va[4], vb[4], vd[4];
#pragma unroll
        for (int q = 0; q < 4; ++q) { const int i = i0 + q * stride; if (i < S * 64) { const int pos = i >> 6, c8 = (i & 63) * 8, h = c8 >> 7;
            const float* L = WSP(float, WS_LDIL) + (size_t)pos * 4 + h; l0[q] = L[0]; l1[q] = L[(size_t)S * 4]; l2[q] = L[(size_t)2 * S * 4];
            const bf16_t* od = WSP(bf16_t, WS_ODIL) + (size_t)pos * 512 + c8; va[q] = *(const u32x4*)od; vb[q] = *(const u32x4*)(od + (size_t)S * 512); vd[q] = *(const u32x4*)(od + (size_t)2 * S * 512); } }
#pragma unroll
        for (int q = 0; q < 4; ++q) { const int i = i0 + q * stride; if (i < S * 64) { const int pos = i >> 6, c8 = (i & 63) * 8;
            const float mx = fmaxf(l0[q], fmaxf(l1[q], l2[q])); const float e0 = __expf(l0[q] - mx), e1 = __expf(l1[q] - mx), e2 = __expf(l2[q] - mx), inv = 1.0f / (e0 + e1 + e2);
            float a[8], b[8], d[8], r[8]; unpack8(va[q], a); unpack8(vb[q], b); unpack8(vd[q], d);
#pragma unroll
            for (int j = 0; j < 8; ++j) r[j] = (e0 * a[j] + e1 * b[j] + e2 * d[j]) * inv;
            *(u32x4*)(WSP(bf16_t, WS_YC) + (size_t)pos * KAB + c8) = pack8(r); } }
    }
}

__device__ __forceinline__ float gelu_tanh_f(float x) { const float u = 0.7978845608028654f * (x + 0.044715f * x * x * x); const float e = __expf(2.0f * u); return 0.5f * x * (1.0f + (1.0f - 2.0f / (e + 1.0f))); }
__device__ __forceinline__ void compress_unit(const Ctx& c, PG8_LAS unsigned char* lds, int u) {
    const int tid = threadIdx.x, wid = __builtin_amdgcn_readfirstlane(tid >> 6), lane = tid & 63, fr = lane & 15, fq = lane >> 4;
    const int which = u >> 7, g = (u >> 5) & 3, n0 = (u & 31) * 16;
    const bf16_t* src = WSP(bf16_t, which ? WS_VC : WS_KC) + g * 128; const bf16_t* w1t = WSP(bf16_t, which ? WS_WCV1T : WS_WCK1T);
    int nrow = n0 + fr; if (nrow > NC - 1) nrow = NC - 1;
    f32x4 acc[8];
#pragma unroll
    for (int i = 0; i < 8; ++i) acc[i] = (f32x4){0.f, 0.f, 0.f, 0.f};
#pragma unroll 4
    for (int kk = 0; kk < 16; ++kk) { const int k = wid * 512 + kk * 32 + fq * 8, l = k >> 7, d = k & 127;
        const bf16x8 a = *(const bf16x8*)(src + (size_t)(16 * nrow + l) * 512 + d);
#pragma unroll
        for (int cs = 0; cs < 8; ++cs) { const bf16x8 b = *(const bf16x8*)(w1t + (size_t)(cs * 16 + fr) * 4096 + k); acc[cs] = __builtin_amdgcn_mfma_f32_16x16x32_bf16(a, b, acc[cs], 0, 0, 0); } }
    PG8_LAS float* part = (PG8_LAS float*)lds;
    PG8_LAS float* hid = part + 8 * 16 * 128;
    __syncthreads();
#pragma unroll
    for (int cs = 0; cs < 8; ++cs)
#pragma unroll
        for (int j = 0; j < 4; ++j) part[(wid * 16 + fq * 4 + j) * 128 + cs * 16 + fr] = acc[cs][j];
    __syncthreads();
    const int row = tid >> 5, c4 = (tid & 31) * 4;
    { const float* cb = WSP(float, WS_CB) + which * 128 + c4; float s[4] = {cb[0], cb[1], cb[2], cb[3]};
#pragma unroll
        for (int w = 0; w < 8; ++w) { const f32x4 v = *(PG8_LAS const f32x4*)(part + (w * 16 + row) * 128 + c4); s[0] += v[0]; s[1] += v[1]; s[2] += v[2]; s[3] += v[3]; }
#pragma unroll
        for (int j = 0; j < 4; ++j) hid[row * 128 + c4 + j] = gelu_tanh_f(s[j]); }
    __syncthreads();
    const float* w2 = which ? c.w_cv2 : c.w_ck2; float o4[4] = {0.f, 0.f, 0.f, 0.f};
#pragma unroll 16
    for (int k = 0; k < 128; ++k) { const float hv = hid[row * 128 + k]; const f32x4 wv = *(const f32x4*)(w2 + (size_t)k * 128 + c4); o4[0] += hv * wv[0]; o4[1] += hv * wv[1]; o4[2] += hv * wv[2]; o4[3] += hv * wv[3]; }
    const bool real = n0 + row < NC; u32x2 w; w.x = real ? pk2(o4[0], o4[1]) : 0u; w.y = real ? pk2(o4[2], o4[3]) : 0u;
    *(u32x2*)(WSP(bf16_t, which ? WS_VCC : WS_KCC) + ((size_t)g * NCP + n0 + row) * 128 + c4) = w;
    __syncthreads();
}

__device__ __forceinline__ void nsa_unit(const Ctx& c, PG8_LAS unsigned char* lds, int u, at::BgConvGU& bg) {
    using namespace at;
    const int tid = threadIdx.x, wid = __builtin_amdgcn_readfirstlane(tid >> 6), lane = tid & 63, r32 = lane & 31, hi = lane >> 5;
    const int g = u & 3, qt = u >> 2, P0 = qt * 64, ql = wid * 8 + (r32 >> 2), pq = P0 + ql, head = g * 4 + (r32 & 3), qmin = P0 + wid * 8;
    PG8_LAS unsigned* imp = (PG8_LAS unsigned*)(lds + OFF_IMP); PG8_LAS unsigned* sel = (PG8_LAS unsigned*)(lds + OFF_SEL);
    for (int i = tid; i < 64 * IMP_LD; i += 512) imp[i] = 0u;
    const float* gt = WSP(float, WS_GNSA) + (size_t)pq * 48 + head * 3;
    bf16_t* yrow0 = WSP(bf16_t, WS_YC) + 512 + (size_t)g * 512;
    auto rowptr = [&](int orow) { return yrow0 + (size_t)(qmin + (orow >> 2)) * KAB + (orow & 3) * 128; };
    bf16x8 qr[8]; f32x16 o[4];
#define ZERO_O() do { _Pragma("unroll") for (int d = 0; d < 4; ++d) _Pragma("unroll") for (int r = 0; r < 16; ++r) o[d][r] = 0.f; } while (0)
    { const bf16_t* Q = WSP(bf16_t, WS_QBR) + (size_t)pq * 2048 + head * 128;
#pragma unroll
      for (int d0 = 0; d0 < 8; ++d0) qr[d0] = *(const bf16x8*)(Q + d0 * 16 + hi * 8); }
    {
        KV kv{WSP(bf16_t, WS_KCC) + (size_t)g * NCP * 128, WSP(bf16_t, WS_VCC) + (size_t)g * NCP * 128, 128, 128};
        const int limm1 = (pq - 31) >> 4;
        PolCmp pol{(qmin - 31) >> 4, (qmin + 7 - 31) >> 4};
        const int ntc = (((P0 + 63 - 31) >> 4) >> 6) + 1;
        float m_reg = -1e30f, l_reg = 0.f; ZERO_O();
        BgNone nobg; flash_loop<1>(pol, lds, kv, 0, ntc, qr, limm1 - 4 * hi, o, m_reg, l_reg, 0.f, nullptr, nobg);
        const float inv_l = l_reg > 0.f ? 1.0f / l_reg : 0.f;
        flash_loop<2>(pol, lds, kv, 0, ntc, qr, limm1 - 4 * hi, o, m_reg, l_reg, inv_l, imp + ql * IMP_LD, nobg);
        store_o<false>(lds, o, gt[0], rowptr);
    }
    __syncthreads();
    {
        int l2 = threadIdx.x; asm volatile("" : "+v"(l2)); l2 &= 63;
        const int m0 = l2, m1 = 64 + l2; const unsigned long long below = (1ull << l2) - 1ull;
        for (int i = 0; i < 4; ++i) {
            const int qa = wid * 8 + i, qb = qa + 4, posa = P0 + qa, posb = P0 + qb, cura = posa >> 6, curb = posb >> 6;
            PG8_LAS const unsigned* rowa = imp + qa * IMP_LD; PG8_LAS const unsigned* rowb = imp + qb * IMP_LD;
            const unsigned k0a = (m0 * 64 <= posa) ? (1u + rowa[m0] + (((m0 == 0) || (m0 == cura) || (m0 == cura - 1)) ? 0x80000000u : 0u)) : 0u;
            const unsigned k1a = (m1 * 64 <= posa) ? (1u + rowa[m1] + (((m1 == cura) || (m1 == cura - 1)) ? 0x80000000u : 0u)) : 0u;
            const unsigned k0b = (m0 * 64 <= posb) ? (1u + rowb[m0] + (((m0 == 0) || (m0 == curb) || (m0 == curb - 1)) ? 0x80000000u : 0u)) : 0u;
            const unsigned k1b = (m1 * 64 <= posb) ? (1u + rowb[m1] + (((m1 == curb) || (m1 == curb - 1)) ? 0x80000000u : 0u)) : 0u;
            unsigned Ta = 0u, Tb = 0u;
            for (int bbit = 31; bbit >= 0; --bbit) { const unsigned ca = Ta | (1u << bbit), cb = Tb | (1u << bbit);
                const int na = __popcll(__ballot(k0a >= ca)) + __popcll(__ballot(k1a >= ca)), nbb = __popcll(__ballot(k0b >= cb)) + __popcll(__ballot(k1b >= cb));
                Ta = na >= 16 ? ca : Ta; Tb = nbb >= 16 ? cb : Tb; }
#define TOPK_TAIL(k0, k1, T, q) do { \
            const unsigned long long g0m = __ballot(k0 > T), g1m = __ballot(k1 > T), e0m = __ballot(k0 == T), e1m = __ballot(k1 == T); \
            const int need = 16 - (__popcll(g0m) + __popcll(g1m));                         \
            const bool s0 = (k0 > T) || ((k0 == T) && (__popcll(e0m & below) < need)); \
            const bool s1 = (k1 > T) || ((k1 == T) && (__popcll(e0m) + __popcll(e1m & below) < need)); \
            const unsigned long long b0 = __ballot(s0), b1 = __ballot(s1); \
            if (l2 == 0) { sel[(q) * 4 + 0] = (unsigned)b0; sel[(q) * 4 + 1] = (unsigned)(b0 >> 32); sel[(q) * 4 + 2] = (unsigned)b1; sel[(q) * 4 + 3] = (unsigned)(b1 >> 32); } } while (0)
            TOPK_TAIL(k0a, k1a, Ta, qa); TOPK_TAIL(k0b, k1b, Tb, qb);
#undef TOPK_TAIL
        }
    }
    __syncthreads();
    { const bf16_t* Q = WSP(bf16_t, WS_QBT) + (size_t)pq * 2048 + head * 128;
#pragma unroll
      for (int d0 = 0; d0 < 8; ++d0) qr[d0] = *(const bf16x8*)(Q + d0 * 16 + hi * 8); }
    {
        KV kv{WSP(bf16_t, WS_KS) + g * 128, WSP(bf16_t, WS_VS) + g * 128, 512, 512};
        PolSel pol{sel + ql * 4, qt};
        float m_reg = -1e30f, l_reg = 0.f; ZERO_O();
        flash_loop<0>(pol, lds, kv, 0, qt + 1, qr, pq - 4 * hi, o, m_reg, l_reg, 0.f, nullptr, bg);
        store_o<true>(lds, o, gt[1] / l_reg, rowptr);
    }
    {
        KV kv{WSP(bf16_t, WS_KW) + g * 128, WSP(bf16_t, WS_VW) + g * 128, 512, 512};
        PolWin pol{qmin, qmin + 7, 512};
        const int j_lo = (P0 - 511 > 0 ? P0 - 511 : 0) / 64;
        float m_reg = -1e30f, l_reg = 0.f; ZERO_O();
        flash_loop<0>(pol, lds, kv, j_lo, qt + 1 - j_lo, qr, pq - 4 * hi, o, m_reg, l_reg, 0.f, nullptr, bg);
        store_o<true>(lds, o, gt[2] / l_reg, rowptr);
    }
#undef ZERO_O
    __syncthreads();
}

constexpr int LDS_CTL_OFF = 136 * 1024;
constexpr int LDS_BYTES = LDS_CTL_OFF + 64;
constexpr int NPHASE = 13;
struct Args { Ctx c; int ph_lo, ph_hi, li, pad; };

__device__ __forceinline__ int ftid_() { int t = threadIdx.x; asm volatile("" : "+v"(t)); return t; }
__global__ void __launch_bounds__(512, 2) mega(Args a) {
    extern __shared__ __attribute__((aligned(16))) unsigned char lds_raw[];
    PG8_LAS unsigned char* lds = (PG8_LAS unsigned char*)lds_raw;
    const Ctx& c = a.c;
    const int tid = threadIdx.x, bid = blockIdx.x, nb = gridDim.x;
    if (tid < 16) ((PG8_LAS unsigned*)(lds + LDS_CTL_OFF))[tid] = 0u;
    __syncthreads();
    XcdBarrier bar = xcd_barrier_post((unsigned*)(c.ws + WS_CTL) + a.li * XCD_BAR_WORDS, (volatile LAS unsigned*)(lds + LDS_CTL_OFF));
    const int lo = a.ph_lo, hi = a.ph_hi;
#ifndef PHMASK
#define PHMASK 0xFFFF
#endif
#define IN(k) (((PHMASK >> (k)) & 1) && lo <= (k) && (k) < hi)
#define SEAM(k) do { if (IN(k) && IN((k) + 1)) xcd_barrier(bar); } while (0)
    unsigned char* ws = c.ws;
    float* tile = (float*)lds_raw;
    if (IN(0)) {
        const int gw = bid * 8 + (tid >> 6), nw = nb * 8;
        if (nb != 256) convert_wt<true>(c.w_gu, DM, NGU, WSP(bf16_t, WS_WGUT), LD8 / 2, 0, NGU, MapGU(), lds, gw, nw);
        if (nb != 256) convert_wt<true>(c.w_down, DFF / 2, DM, WSP(bf16_t, WS_WDT), LDA8 / 2, 0, DM, MapId(), lds, gw, nw);
        if (nb != 256) convert_wt<true>(c.w_down + (size_t)(DFF / 2) * DM, DFF / 2, DM, WSP(bf16_t, WS_WDT), LDA8 / 2, DFF / 4, DM, MapId(), lds, gw, nw);
        if (nb != 256) convert_wt<false>(c.w_out, DM, DM, WSP(bf16_t, WS_WOT), LDK, 0, DM, MapId(), lds, gw, nw);
        if (nb != 256) convert_wt<true>(c.w_ple_gate, DM, DM, WSP(bf16_t, WS_WGT), LD8 / 2, 0, DM, MapId(), lds, gw, nw);
        if (nb != 256) { convert_wt<false>(c.w_a, 512, DM, WSP(bf16_t, WS_WABT), KAB, 0, DM, MapId(), lds, gw, nw);
                         convert_wt<false>(c.w_b, 2048, DM, WSP(bf16_t, WS_WABT), KAB, 512, DM, MapId(), lds, gw, nw); }
        convert_wt<false>(c.w_ple, PLE, DM, WSP(bf16_t, WS_WPT), PLE, 0, DM, MapId(), lds, gw, nw);
        convert_wt<false>(c.w_ck1, 4096, 128, WSP(bf16_t, WS_WCK1T), 4096, 0, 128, MapId(), lds, gw, nw);
        convert_wt<false>(c.w_cv1, 4096, 128, WSP(bf16_t, WS_WCV1T), 4096, 0, 128, MapId(), lds, gw, nw);
        convert_wt<false>(c.w_in, DM, IN_W, WSP(bf16_t, WS_W1T), LDK, 0, N1P, MapIn(), lds, gw, nw);
        convert_wt<true>(c.w_in, DM, IN_W, WSP(bf16_t, WS_W1G8), LD8 / 2, 0, 8192, MapGM(), lds, gw, nw);
        rmsnorm_rows(c.x, c.g_mix_pre, WSP(bf16_t, WS_HB), WSP(unsigned char, WS_H8), bid, nb);
        for (size_t i = (size_t)bid * 512 + tid; i < (size_t)S * PLE / 4; i += (size_t)nb * 512) { const f32x4 v = *(const f32x4*)(c.p + i * 4); u32x2 w; w.x = pk2(v[0], v[1]); w.y = pk2(v[2], v[3]); *(u32x2*)(WSP(bf16_t, WS_PB) + i * 4) = w; }
        for (int i = bid * 512 + tid; i < S * 64; i += nb * 512) { const int pos = i >> 6, f = i & 63; double iv = 1.0; for (int q = 0; q < f; ++q) iv *= 0.8659643233600653;
            const float ang = (float)pos * (float)iv; double rev = (double)ang * 0.15915494309189535; rev -= rint(rev);
            WSP(float, WS_ROPEC)[i] = __builtin_amdgcn_cosf((float)rev); WSP(float, WS_ROPES)[i] = __builtin_amdgcn_sinf((float)rev); }
        for (int sl = bid; sl < 256; sl += nb) if (tid < 256) { const int which = tid >> 7, col = tid & 127; const float* pe = which ? c.pe_cv : c.pe_ck; const float* w1 = which ? c.w_cv1 : c.w_ck1; float s_ = 0.f;
#pragma unroll
            for (int k = sl * 16; k < sl * 16 + 16; ++k) s_ += pe[k] * w1[(size_t)k * 128 + col];
            WSP(float, WS_CBP)[sl * 256 + tid] = s_; }
        __syncthreads();
    }
    SEAM(0);
    if (IN(1)) {
        { pg8::Gemm g{WSP(bf16_t, WS_HB), WSP(bf16_t, WS_W1T), S, N1P, DM, LDK, LDK}; pg8::StaticOrder so; so.init(S, N1P, nb, bid); pg8::gemm_phase(lds, g, so, EpiIn{ws}); }
        { pg8::Gemm g{WSP(bf16_t, WS_H8), WSP(bf16_t, WS_W1G8), S, 8192, DM / 2, LD8 / 2, LD8 / 2}; pg8::StaticOrder so; so.init(S, 8192, nb, bid); pg8::gemm_phase<EpiGate8, pg8::StaticOrder, true>(lds, g, so, EpiGate8{WSP(bf16_t, WS_GMIX)}); }
        if (bid == nb - 1 && tid < 256) { float s_ = 0.f;
#pragma unroll 16
            for (int sl = 0; sl < 256; ++sl) s_ += WSP(float, WS_CBP)[sl * 256 + tid];
            WSP(float, WS_CB)[tid] = s_; }
        if (nb == 256 && bid >= 224) { __syncthreads(); convert_wt<true>(c.w_ple_gate, DM, DM, WSP(bf16_t, WS_WGT), LD8 / 2, 0, DM, MapId(), lds, (bid - 224) * 8 + (tid >> 6), 32 * 8); __syncthreads(); }
    }
    SEAM(1);
    if (IN(2)) {
        for (int u = bid; u < 384 + 256; u += nb) { if (u < 384) dilated_unit(c, lds, u); else compress_unit(c, lds, u - 384); }
        if (nb == 256 && bid >= 128) { __syncthreads(); convert_wt<false>(c.w_out, DM, DM, WSP(bf16_t, WS_WOT), LDK, 0, DM, MapId(), lds, (bid - 128) * 8 + (tid >> 6), 128 * 8); __syncthreads(); }
    }
    SEAM(2);
    if (IN(3)) {
        dilated_combine(c, bid, nb);
        at::BgConvGU bgc; { const int w_ = __builtin_amdgcn_readfirstlane(ftid_() >> 6); bgc.init(c.w_gu, c.ws + WS_WGUT, c.w_down, c.ws + WS_WDT, c.w_a, c.w_b, c.ws + WS_WABT, lds + at::OFF_IMP + w_ * 4096, bid * 8 + w_, nb == 256); }
        for (int i = bid; i < 256; i += nb) { nsa_unit(c, lds, 256 + i, bgc); nsa_unit(c, lds, 255 - i, bgc); }
        while (bgc.want()) { bgc.issue(ftid_() & 63); asm volatile("s_waitcnt vmcnt(0)" ::: "memory"); bgc.commit(ftid_() & 63); }
    }
    SEAM(3);
    if (IN(4)) {
        { pg8::Gemm g{WSP(bf16_t, WS_YC), WSP(bf16_t, WS_WABT), S, DM, 512, KAB, KAB}; pg8::StaticOrder so; so.init(S, DM, nb, bid); pg8::gemm_phase(lds, g, so, EpiGateA{WSP(bf16_t, WS_GMIX), WSP(bf16_t, WS_MG)}); }
        { pg8::Gemm g{WSP(bf16_t, WS_YC) + 512, WSP(bf16_t, WS_WABT) + 512, S, DM, 2048, KAB, KAB}; pg8::StaticOrder so; so.init(S, DM, nb, bid); pg8::gemm_phase(lds, g, so, EpiGateB{WSP(bf16_t, WS_GMIX), WSP(bf16_t, WS_MG)}); }
    }
    SEAM(4);
    if (IN(5)) { pg8::Gemm g{WSP(bf16_t, WS_MG), WSP(bf16_t, WS_WOT), S, DM, DM, LDK, LDK}; pg8::StaticOrder so; so.init(S, DM, nb, bid); pg8::gemm_phase(lds, g, so, EpiSS{WSP(bf16_t, WS_MX), WSP(float, WS_PART), nullptr, 1.0f, nullptr}); }
    SEAM(5);
    if (IN(6)) {
        { int kp = PLE; asm volatile("" : "+s"(kp));
          pg8::Gemm g{WSP(bf16_t, WS_PB), WSP(bf16_t, WS_WPT), S, DM, kp, PLE, PLE}; pg8::StaticOrder so; so.init(S, DM, nb, bid); pg8::gemm_phase(lds, g, so, EpiPlain{WSP(bf16_t, WS_MG)}); }
        resnorm_rows<false, true, true, true>(c.x, WSP(bf16_t, WS_MX), WSP(float, WS_PART), c.g_mix_post, c.g_ffn_pre, WSP(bf16_t, WS_XR), WSP(bf16_t, WS_HB), bid, nb, WSP(float, WS_R2));
    }
    SEAM(6);
    if (IN(7)) { pg8::Gemm g{WSP(bf16_t, WS_HB), WSP(bf16_t, WS_WGUT), S, NGU, DM / 2, LD8 / 2, LD8 / 2}; pg8::StaticOrder so; so.init(S, NGU, nb, bid); pg8::gemm_phase<EpiSwiglu, pg8::StaticOrder, true>(lds, g, so, EpiSwiglu{WSP(bf16_t, WS_ACT), WSP(float, WS_R2)}); }
    if (IN(7) && nb == 256 && bid >= 192) { __syncthreads(); convert_wt<true>(c.w_down + (size_t)(DFF / 2) * DM, DFF / 2, DM, WSP(bf16_t, WS_WDT), LDA8 / 2, DFF / 4, DM, MapId(), lds, (bid - 192) * 8 + (tid >> 6), 64 * 8); __syncthreads(); }
    SEAM(7);
    if (IN(8)) { pg8::Gemm g{WSP(bf16_t, WS_ACT), WSP(bf16_t, WS_WDT), S, DM, DFF / 2, LDA8 / 2, LDA8 / 2}; pg8::StaticOrder so; so.init(S, DM, nb, bid); pg8::gemm_phase<EpiSS, pg8::StaticOrder, true>(lds, g, so, EpiSS{WSP(bf16_t, WS_MX), WSP(float, WS_PART), nullptr, 1.0f / W8SCALE, nullptr}); }
    SEAM(8);
    if (IN(9)) resnorm_rows<true, true, true, true>(WSP(bf16_t, WS_XR), WSP(bf16_t, WS_MX), WSP(float, WS_PART), c.g_ffn_post, c.g_ple_pre, WSP(bf16_t, WS_XR), WSP(bf16_t, WS_HB), bid, nb, WSP(float, WS_R2));
    SEAM(9);
    if (IN(10)) { pg8::Gemm g{WSP(bf16_t, WS_HB), WSP(bf16_t, WS_WGT), S, DM, DM / 2, LD8 / 2, LD8 / 2}; pg8::StaticOrder so; so.init(S, DM, nb, bid); pg8::gemm_phase<EpiSS, pg8::StaticOrder, true>(lds, g, so, EpiSS{WSP(bf16_t, WS_MX), WSP(float, WS_PART), WSP(bf16_t, WS_MG), 1.0f / W8SCALE, WSP(float, WS_R2)}); }
    SEAM(10);
    if (IN(11)) resnorm_rows<true, false, false>(WSP(bf16_t, WS_XR), WSP(bf16_t, WS_MX), WSP(float, WS_PART), c.g_ple_post, nullptr, c.out, nullptr, bid, nb);
#undef IN
#undef SEAM
}
}

extern "C" void kernel_launch(void* const* d_in, const int* in_sizes, int n_in, void* d_out, int out_size, void* d_ws, size_t ws_size, hipStream_t stream) {
    using namespace hk;
    if (n_in != 22 || ws_size < WS_END) return;
    static int grid = 0;
    if (grid == 0) {
        int dev = 0, cus = 0, per_cu = 0;
        hipGetDevice(&dev); hipDeviceGetAttribute(&cus, hipDeviceAttributeMultiprocessorCount, dev);
        hipFuncSetAttribute((const void*)mega, hipFuncAttributeMaxDynamicSharedMemorySize, LDS_BYTES);
        hipOccupancyMaxActiveBlocksPerMultiprocessor(&per_cu, (const void*)mega, 512, LDS_BYTES);
        (void)hipGetLastError();
        grid = cus > 0 ? cus : 256;
    }
    Args a{};
    const float** f = (const float**)&a.c;
    for (int i = 0; i < 22; ++i) f[i] = (const float*)d_in[i];
    a.c.out = (float*)d_out; a.c.ws = (unsigned char*)d_ws;
    Ctx c = a.c;
    hipMemsetAsync((char*)d_ws + WS_CTL, 0, 65536, stream);
#ifdef PROBE_LO
    a.ph_lo = 0; a.ph_hi = PROBE_HI; a.li = 0;
    hipLaunchKernelGGL(mega, dim3(grid), dim3(512), LDS_BYTES, stream, a);
    a.ph_lo = PROBE_LO; a.ph_hi = NPHASE; a.li = 1;
    hipLaunchKernelGGL(mega, dim3(grid), dim3(512), LDS_BYTES, stream, a);
#else
    a.ph_lo = 0; a.ph_hi = NPHASE; a.li = 0;
    hipLaunchKernelGGL(mega, dim3(grid), dim3(512), LDS_BYTES, stream, a);
#endif
}
```

```cpp
#include <hip/hip_runtime.h>
#include <stdint.h>

namespace hk {
typedef unsigned short bf16_t;
typedef short bf16x8 __attribute__((ext_vector_type(8)));
typedef float f32x4 __attribute__((ext_vector_type(4)));
typedef unsigned u32x4 __attribute__((ext_vector_type(4)));
typedef unsigned u32x2 __attribute__((ext_vector_type(2)));
typedef int v4i __attribute__((ext_vector_type(4)));
typedef int v8i __attribute__((ext_vector_type(8)));

constexpr int S = 8192, DM = 4096, HD = 128;
constexpr int IN_W = 17968, N1P = 39 * 256;
constexpr int DFF = 11008, NGU = 2 * DFF;
constexpr int PLE = 256;
constexpr int LDK = DM + 64;
constexpr int LD8 = 4224;
constexpr int LDA8 = DFF + 128;
constexpr float W8SCALE = 64.0f;
constexpr int KAB = 512 + 2048;
constexpr int NC = 511, NCP = 512, NSEL = 128;
constexpr float EPS = 1e-6f;
constexpr float QSCALE = 0.08838834764831845f;
constexpr int C_QA = 0, C_KA = 1536, C_VA = 3072, C_QB = 4608, C_KC = 6656, C_VC = 7168, C_KS = 7680, C_VS = 8192, C_KW = 8704, C_VW = 9216, C_GN = 9728, C_GM = 9776;

constexpr size_t al(size_t x) { return (x + 255) & ~(size_t)255; }
constexpr size_t WS_CTL = 0;
constexpr size_t WS_R2 = 32768;
constexpr size_t WS_W1T = 65536;
constexpr size_t WS_WGUT = WS_W1T + al((size_t)N1P * LDK * 2);
constexpr size_t WS_WDT = WS_WGUT + al((size_t)NGU * LDK * 2);
constexpr size_t WS_WOT = WS_WDT + al((size_t)DM * DFF * 2);
constexpr size_t WS_WGT = WS_WOT + al((size_t)DM * LDK * 2);
constexpr size_t WS_WABT = WS_WGT + al((size_t)DM * LDK * 2);
constexpr size_t WS_WPT = WS_WABT + al((size_t)DM * KAB * 2);
constexpr size_t WS_WCK1T = WS_WPT + al((size_t)DM * PLE * 2);
constexpr size_t WS_WCV1T = WS_WCK1T + al((size_t)128 * 4096 * 2);
constexpr size_t WS_ROPEC = WS_WCV1T + al((size_t)128 * 4096 * 2);
constexpr size_t WS_ROPES = WS_ROPEC + al((size_t)S * 64 * 4);
constexpr size_t WS_CB = WS_ROPES + al((size_t)S * 64 * 4);
constexpr size_t WS_HB = WS_CB + al(256 * 4);
constexpr size_t WS_PB = WS_HB + al((size_t)S * LDK * 2);
constexpr size_t WS_QA = WS_PB + al((size_t)S * PLE * 2);
constexpr size_t WS_KA = WS_QA + al((size_t)S * 1536 * 2);
constexpr size_t WS_VA = WS_KA + al((size_t)S * 1536 * 2);
constexpr size_t WS_QBR = WS_VA + al((size_t)S * 1536 * 2);
constexpr size_t WS_QBT = WS_QBR + al((size_t)S * 2048 * 2);
constexpr size_t WS_KC = WS_QBT + al((size_t)S * 2048 * 2);
constexpr size_t WS_VC = WS_KC + al((size_t)S * 512 * 2);
constexpr size_t WS_KS = WS_VC + al((size_t)S * 512 * 2);
constexpr size_t WS_VS = WS_KS + al((size_t)S * 512 * 2);
constexpr size_t WS_KW = WS_VS + al((size_t)S * 512 * 2);
constexpr size_t WS_VW = WS_KW + al((size_t)S * 512 * 2);
constexpr size_t WS_GMIX = WS_VW + al((size_t)S * 512 * 2);
constexpr size_t WS_PROJ_END = WS_GMIX + al((size_t)S * 8192 * 2);
constexpr size_t WS_ACT = WS_QA;
static_assert(WS_ACT + (size_t)S * DFF * 2 <= WS_PROJ_END, "act alias");
constexpr size_t WS_GNSA = WS_PROJ_END;
constexpr size_t WS_KCC = WS_GNSA + al((size_t)S * 48 * 4);
constexpr size_t WS_VCC = WS_KCC + al((size_t)4 * NCP * 128 * 2);
constexpr size_t WS_YC = WS_VCC + al((size_t)4 * NCP * 128 * 2);
constexpr size_t WS_MG = WS_YC + al((size_t)S * KAB * 2);
constexpr size_t WS_MX = WS_MG + al((size_t)S * LDK * 2);
constexpr size_t WS_PART = WS_MX + al((size_t)S * DM * 2);
constexpr size_t WS_CBP = WS_PART + al((size_t)S * 64 * 4);
constexpr size_t WS_XR = WS_CBP + al((size_t)256 * 256 * 4);
constexpr size_t WS_W1G8 = WS_XR + al((size_t)S * DM * 2);
constexpr size_t WS_H8 = WS_W1G8 + al((size_t)8192 * 4224);
constexpr size_t WS_END = WS_H8 + al((size_t)S * 4224);

#define PG8_LAS __attribute__((address_space(3)))
__device__ __forceinline__ bf16_t f2bf(float f) { unsigned u = __float_as_uint(f); u += 0x7FFFu + ((u >> 16) & 1u); return (bf16_t)(u >> 16); }
__device__ __forceinline__ float bf2f(bf16_t b) { return __uint_as_float(((unsigned)b) << 16); }
__device__ __forceinline__ unsigned pk2(float lo, float hi) { return (unsigned)f2bf(lo) | ((unsigned)f2bf(hi) << 16); }
__device__ __forceinline__ float sigmoidf_(float x) { return __builtin_amdgcn_rcpf(1.0f + __expf(-x)); }
__device__ __forceinline__ float wave_sum(float v) { for (int o = 32; o >= 1; o >>= 1) v += __shfl_xor(v, o); return v; }
__device__ __forceinline__ float wave_max(float v) { for (int o = 32; o >= 1; o >>= 1) v = fmaxf(v, __shfl_xor(v, o)); return v; }
__host__ __device__ __forceinline__ int perm32(int rho) { const int n = rho >> 4, i = rho & 15; return 8 * (i >> 2) + 4 * n + (i & 3); }
__device__ __forceinline__ void unpack8(u32x4 w, float (&v)[8]) {
    v[0] = __uint_as_float(w.x << 16); v[1] = __uint_as_float(w.x & 0xffff0000u); v[2] = __uint_as_float(w.y << 16); v[3] = __uint_as_float(w.y & 0xffff0000u);
    v[4] = __uint_as_float(w.z << 16); v[5] = __uint_as_float(w.z & 0xffff0000u); v[6] = __uint_as_float(w.w << 16); v[7] = __uint_as_float(w.w & 0xffff0000u);
}
__device__ __forceinline__ u32x4 pack8(const float (&v)[8]) { u32x4 w; w.x = pk2(v[0], v[1]); w.y = pk2(v[2], v[3]); w.z = pk2(v[4], v[5]); w.w = pk2(v[6], v[7]); return w; }

struct Ctx {
    const float* x; const float* p; const float* g_mix_pre; const float* w_in; const float* pe_ck; const float* w_ck1; const float* w_ck2;
    const float* pe_cv; const float* w_cv1; const float* w_cv2; const float* w_a; const float* w_b; const float* w_out; const float* g_mix_post;
    const float* g_ffn_pre; const float* w_gu; const float* w_down; const float* g_ffn_post; const float* g_ple_pre; const float* w_ple_gate;
    const float* w_ple; const float* g_ple_post; float* out; unsigned char* ws;
};
#define WSP(T, off) ((T*)(c.ws + (off)))

struct MapIn {
    __device__ __forceinline__ int operator()(int n) const {
        const int t = n >> 8, cc = n & 255;
        auto rope = [&](int base, int tt) { const int half = cc >> 7, c7 = cc & 127; return base + (2 * tt + (c7 >> 6)) * 128 + half * 64 + (c7 & 63); };
        if (t < 6) return rope(C_QA, t);
        if (t < 12) return rope(C_KA, t - 6);
        if (t < 18) return C_VA + (t - 12) * 256 + cc;
        if (t < 26) return rope(C_QB, t - 18);
        if (t < 28) return C_KC + (t - 26) * 256 + cc;
        if (t < 30) return C_VC + (t - 28) * 256 + cc;
        if (t < 32) return rope(C_KS, t - 30);
        if (t < 34) return C_VS + (t - 32) * 256 + cc;
        if (t < 36) return rope(C_KW, t - 34);
        if (t < 38) return C_VW + (t - 36) * 256 + cc;
        return cc < 48 ? C_GN + cc : -1;
    }
};
struct MapGM { __device__ __forceinline__ int operator()(int n) const { return C_GM + n; } };
struct MapGU { __device__ __forceinline__ int operator()(int n) const { const int t = n >> 8, cc = n & 255; return cc < 128 ? t * 128 + cc : DFF + t * 128 + (cc - 128); } };
struct MapId { __device__ __forceinline__ int operator()(int n) const { return n; } };

__device__ __forceinline__ unsigned pk4_fp8(float a, float b, float c, float d) { int w = 0; w = __builtin_amdgcn_cvt_pk_fp8_f32(a, b, w, false); w = __builtin_amdgcn_cvt_pk_fp8_f32(c, d, w, true); return (unsigned)w; }
template <bool F8, class Map>
__device__ __forceinline__ void convert_wt(const float* __restrict__ W, int K, int ldw, bf16_t* __restrict__ Bt, int ldb, int koff, int N, Map map, PG8_LAS unsigned char* lds, int gw, int nw) {
    const int lane = threadIdx.x & 63, wid = __builtin_amdgcn_readfirstlane((int)(threadIdx.x >> 6));
    constexpr int KI = F8 ? 128 : 64;
    const int tn = N / 64, tk = K / KI, ng = (tn + 3) / 4, nt = ng * tk * 4;
    PG8_LAS unsigned char* wl = lds + wid * 9216;
    for (int t = gw; t < nt; t += nw) {
        const int nblk = (t / (4 * tk)) * 4 + (t & 3), k0 = ((t >> 2) % tk) * KI, n0 = nblk * 64;
        if (nblk >= tn) continue;
        const int src = map(n0 + lane);
#pragma unroll
        for (int half = 0; half < (F8 ? 2 : 1); ++half) {
            const float* p = W + (size_t)(k0 + half * 64) * ldw + (src >= 0 ? src : 0);
            float v[64];
#pragma unroll
            for (int kk = 0; kk < 64; ++kk) v[kk] = __builtin_nontemporal_load(p + (size_t)kk * ldw);
            if (src < 0) {
#pragma unroll
                for (int kk = 0; kk < 64; ++kk) v[kk] = 0.f; }
            if (F8) {
#pragma unroll
                for (int j = 0; j < 4; ++j) { u32x4 w; w.x = pk4_fp8(v[16 * j] * W8SCALE, v[16 * j + 1] * W8SCALE, v[16 * j + 2] * W8SCALE, v[16 * j + 3] * W8SCALE); w.y = pk4_fp8(v[16 * j + 4] * W8SCALE, v[16 * j + 5] * W8SCALE, v[16 * j + 6] * W8SCALE, v[16 * j + 7] * W8SCALE);
                    w.z = pk4_fp8(v[16 * j + 8] * W8SCALE, v[16 * j + 9] * W8SCALE, v[16 * j + 10] * W8SCALE, v[16 * j + 11] * W8SCALE); w.w = pk4_fp8(v[16 * j + 12] * W8SCALE, v[16 * j + 13] * W8SCALE, v[16 * j + 14] * W8SCALE, v[16 * j + 15] * W8SCALE);
                    *(PG8_LAS u32x4*)(wl + lane * 144 + half * 64 + j * 16) = w; }
            } else {
#pragma unroll
                for (int j = 0; j < 8; ++j) { u32x4 w; w.x = pk2(v[8 * j], v[8 * j + 1]); w.y = pk2(v[8 * j + 2], v[8 * j + 3]); w.z = pk2(v[8 * j + 4], v[8 * j + 5]); w.w = pk2(v[8 * j + 6], v[8 * j + 7]);
                    *(PG8_LAS u32x4*)(wl + lane * 144 + j * 16) = w; }
            }
        }
        asm volatile("s_waitcnt lgkmcnt(0)" ::: "memory");
        bf16_t* o = Bt + (size_t)(n0 + (lane >> 3)) * ldb + koff + (F8 ? (k0 >> 1) : k0) + (lane & 7) * 8;
#pragma unroll
        for (int i = 0; i < 8; ++i) { const u32x4 w = *(PG8_LAS const u32x4*)(wl + (i * 8 + (lane >> 3)) * 144 + (lane & 7) * 16); *(u32x4*)(o + (size_t)i * 8 * ldb) = w; }
        asm volatile("s_waitcnt lgkmcnt(0)" ::: "memory");
    }
}

__device__ __forceinline__ void rmsnorm_rows(const float* __restrict__ x, const float* __restrict__ g, bf16_t* __restrict__ o, unsigned char* __restrict__ o8, int bid, int nb) {
    const int wid = threadIdx.x >> 6, lane = threadIdx.x & 63, nw = blockDim.x >> 6;
    for (int row = bid * nw + wid; row < S; row += nb * nw) {
        const float* xr = x + (size_t)row * DM; f32x4 v[16]; float ss = 0.f;
#pragma unroll
        for (int i = 0; i < 16; ++i) { v[i] = __builtin_nontemporal_load((const f32x4*)(xr + i * 256 + lane * 4)); ss += v[i][0] * v[i][0] + v[i][1] * v[i][1] + v[i][2] * v[i][2] + v[i][3] * v[i][3]; }
        ss = wave_sum(ss); const float r = rsqrtf(ss * (1.0f / DM) + EPS);
#pragma unroll
        for (int i = 0; i < 16; ++i) { const f32x4 gg = *(const f32x4*)(g + i * 256 + lane * 4); u32x2 w; w.x = pk2(v[i][0] * r * gg[0], v[i][1] * r * gg[1]); w.y = pk2(v[i][2] * r * gg[2], v[i][3] * r * gg[3]);
            *(u32x2*)(o + (size_t)row * LDK + i * 256 + lane * 4) = w;
            *(unsigned*)(o8 + (size_t)row * LD8 + i * 256 + lane * 4) = pk4_fp8(v[i][0] * r * gg[0], v[i][1] * r * gg[1], v[i][2] * r * gg[2], v[i][3] * r * gg[3]); }
    }
}

struct EpiIn {
    unsigned char* ws;
    __device__ __forceinline__ void rope_store(bf16_t* dst, int ld, int head, int row, int c8, const float (&lo)[8], const float (&hi)[8], bf16_t* raw) const {
        const int hl = c8 >> 6, i0 = c8 & 63; const float* ct = (const float*)(ws + WS_ROPEC) + (size_t)row * 64 + i0; const float* st = (const float*)(ws + WS_ROPES) + (size_t)row * 64 + i0;
        float a[8], b[8];
#pragma unroll
        for (int j = 0; j < 8; ++j) { const float cs = ct[j], sn = st[j]; a[j] = lo[j] * cs - hi[j] * sn; b[j] = hi[j] * cs + lo[j] * sn; }
        bf16_t* o = dst + (size_t)row * ld + (head + hl) * 128 + i0; *(u32x4*)o = pack8(a); *(u32x4*)(o + 64) = pack8(b);
        if (raw) { bf16_t* r = raw + (size_t)row * ld + (head + hl) * 128 + i0; *(u32x4*)r = pack8(lo); *(u32x4*)(r + 64) = pack8(hi); }
    }
    __device__ __forceinline__ void plain_store(bf16_t* dst, int ld, int col0, int row, int c8, const float (&lo)[8], const float (&hi)[8]) const {
        bf16_t* o = dst + (size_t)row * ld + col0 + c8; *(u32x4*)o = pack8(lo); *(u32x4*)(o + 128) = pack8(hi);
    }
    __device__ __forceinline__ float rowscale(int) const { return 1.f; }
    __device__ __forceinline__ void apply(int row, int t, int c8, const float (&lo)[8], const float (&hi)[8], float) const {
        if (t < 6) rope_store((bf16_t*)(ws + WS_QA), 1536, 2 * t, row, c8, lo, hi, nullptr);
        else if (t < 12) rope_store((bf16_t*)(ws + WS_KA), 1536, 2 * (t - 6), row, c8, lo, hi, nullptr);
        else if (t < 18) plain_store((bf16_t*)(ws + WS_VA), 1536, (t - 12) * 256, row, c8, lo, hi);
        else if (t < 26) rope_store((bf16_t*)(ws + WS_QBT), 2048, 2 * (t - 18), row, c8, lo, hi, (bf16_t*)(ws + WS_QBR));
        else if (t < 28) plain_store((bf16_t*)(ws + WS_KC), 512, (t - 26) * 256, row, c8, lo, hi);
        else if (t < 30) plain_store((bf16_t*)(ws + WS_VC), 512, (t - 28) * 256, row, c8, lo, hi);
        else if (t < 32) rope_store((bf16_t*)(ws + WS_KS), 512, 2 * (t - 30), row, c8, lo, hi, nullptr);
        else if (t < 34) plain_store((bf16_t*)(ws + WS_VS), 512, (t - 32) * 256, row, c8, lo, hi);
        else if (t < 36) rope_store((bf16_t*)(ws + WS_KW), 512, 2 * (t - 34), row, c8, lo, hi, nullptr);
        else if (t < 38) plain_store((bf16_t*)(ws + WS_VW), 512, (t - 36) * 256, row, c8, lo, hi);
        else if (c8 < 48) { float* o = (float*)(ws + WS_GNSA) + (size_t)row * 48 + c8;
#pragma unroll
            for (int j = 0; j < 8; ++j) o[j] = sigmoidf_(lo[j]); }
    }
};
struct EpiGate8 {
    bf16_t* gm;
    __device__ __forceinline__ float rowscale(int) const { return 1.f; }
    __device__ __forceinline__ void apply(int row, int pn, int c8, const float (&lo)[8], const float (&hi)[8], float) const {
        float a[8], b[8];
#pragma unroll
        for (int j = 0; j < 8; ++j) { a[j] = sigmoidf_(lo[j] * (1.0f / W8SCALE)); b[j] = sigmoidf_(hi[j] * (1.0f / W8SCALE)); }
        bf16_t* o = gm + (size_t)row * 8192 + pn * 256 + c8; *(u32x4*)o = pack8(a); *(u32x4*)(o + 128) = pack8(b);
    }
};
struct EpiGateA {
    const bf16_t* gm; bf16_t* out;
    __device__ __forceinline__ float rowscale(int) const { return 1.f; }
    __device__ __forceinline__ void apply(int row, int pn, int c8, const float (&lo)[8], const float (&hi)[8], float) const {
        float ga[8], a[8], b[8]; const int col = pn * 256 + c8;
        unpack8(*(const u32x4*)(gm + (size_t)row * 8192 + col), ga);
#pragma unroll
        for (int j = 0; j < 8; ++j) a[j] = lo[j] * ga[j];
        unpack8(*(const u32x4*)(gm + (size_t)row * 8192 + col + 128), ga);
#pragma unroll
        for (int j = 0; j < 8; ++j) b[j] = hi[j] * ga[j];
        bf16_t* o = out + (size_t)row * LDK + col; *(u32x4*)o = pack8(a); *(u32x4*)(o + 128) = pack8(b);
    }
};
struct EpiGateB {
    const bf16_t* gm; bf16_t* out;
    __device__ __forceinline__ float rowscale(int) const { return 1.f; }
    __device__ __forceinline__ void apply(int row, int pn, int c8, const float (&lo)[8], const float (&hi)[8], float) const {
        float gb[8], t[8], a[8], b[8]; const int col = pn * 256 + c8; bf16_t* o = out + (size_t)row * LDK + col;
        unpack8(*(const u32x4*)(gm + (size_t)row * 8192 + 4096 + col), gb); unpack8(*(const u32x4*)o, t);
#pragma unroll
        for (int j = 0; j < 8; ++j) a[j] = t[j] + lo[j] * gb[j];
        unpack8(*(const u32x4*)(gm + (size_t)row * 8192 + 4096 + col + 128), gb); unpack8(*(const u32x4*)(o + 128), t);
#pragma unroll
        for (int j = 0; j < 8; ++j) b[j] = t[j] + hi[j] * gb[j];
        *(u32x4*)o = pack8(a); *(u32x4*)(o + 128) = pack8(b);
    }
};
struct EpiSS {
    bf16_t* out; float* part; const bf16_t* P; float sc; const float* r2;
    __device__ __forceinline__ float rowscale(int row) const { return r2 ? sc * r2[row] : sc; }
    __device__ __forceinline__ void apply(int row, int pn, int c8, const float (&lo)[8], const float (&hi)[8], float rs) const {
        float a[8], b[8];
        if (P) { float pa[8], pb[8]; unpack8(*(const u32x4*)(P + (size_t)row * LDK + pn * 256 + c8), pa); unpack8(*(const u32x4*)(P + (size_t)row * LDK + pn * 256 + 128 + c8), pb);
#pragma unroll
            for (int j = 0; j < 8; ++j) { a[j] = pa[j] * sigmoidf_(lo[j] * rs); b[j] = pb[j] * sigmoidf_(hi[j] * rs); } }
        else {
#pragma unroll
            for (int j = 0; j < 8; ++j) { a[j] = lo[j] * rs; b[j] = hi[j] * rs; } }
        float s = 0.f;
#pragma unroll
        for (int j = 0; j < 8; ++j) s += a[j] * a[j] + b[j] * b[j];
        s += __shfl_xor(s, 16); s += __shfl_xor(s, 32);
        if ((threadIdx.x & 63) < 16) part[(size_t)row * 64 + pn * 4 + (c8 >> 5)] = s;
        bf16_t* o = out + (size_t)row * DM + pn * 256 + c8; *(u32x4*)o = pack8(a); *(u32x4*)(o + 128) = pack8(b);
    }
};
struct EpiSwiglu {
    bf16_t* act; const float* r2;
    __device__ __forceinline__ float rowscale(int row) const { return r2[row] * (1.0f / W8SCALE); }
    __device__ __forceinline__ void apply(int row, int pn, int c8, const float (&lo)[8], const float (&hi)[8], float rs) const {
        float a[8];
#pragma unroll
        for (int j = 0; j < 8; ++j) { const float gv = lo[j] * rs, uv = hi[j] * rs; a[j] = gv * sigmoidf_(gv) * uv; }
        u32x2 w; w.x = pk4_fp8(a[0], a[1], a[2], a[3]); w.y = pk4_fp8(a[4], a[5], a[6], a[7]); *(u32x2*)((unsigned char*)act + (size_t)row * LDA8 + pn * 128 + c8) = w;
    }
};
struct EpiPlain {
    bf16_t* out;
    __device__ __forceinline__ float rowscale(int) const { return 1.f; }
    __device__ __forceinline__ void apply(int row, int pn, int c8, const float (&lo)[8], const float (&hi)[8], float) const {
        bf16_t* o = out + (size_t)row * LDK + pn * 256 + c8; *(u32x4*)o = pack8(lo); *(u32x4*)(o + 128) = pack8(hi);
    }
};

namespace pg8 {
constexpr int BM = 256, BK = 64, HALF = 128, HTB = HALF * BK * 2, STAGE_BYTES = 8 * HTB, NXCD = 8, WGM = 8;
__host__ __device__ __forceinline__ int lds_byte(int r, int c) { const int st = (r >> 4) * 2 + (c >> 5), rr = r & 15, cc = c & 31, ob = rr * 64 + cc * 2; return st * 1024 + (ob ^ (((ob >> 9) & 1) << 5)); }
__host__ __device__ __forceinline__ void stage_rc(int b, int& R, int& C) { const int st = b / 1024, sb = b % 1024, swz = sb ^ (((sb >> 9) & 1) << 5); R = (st >> 1) * 16 + swz / 64; C = (st & 1) * 32 + (swz % 64) / 2; }
struct Unit { int pm, pn; };
struct Gemm { const bf16_t* A; const bf16_t* Bt; int M, N, K, lda, ldb; };
struct StaticOrder {
    int nM, nN, nwg, G, c;
    __host__ __device__ void init(int M, int N, int G_, int c_) { nM = M / BM; nN = N / BM; nwg = nM * nN; G = G_; c = c_; }
    __host__ __device__ bool next(int i, Unit& u) const {
        const long L = (long)i * G + c; if (L >= nwg) return false;
        int wgid = (int)L; { const int q = nwg / NXCD, r = nwg % NXCD, xcd = wgid % NXCD, off = wgid / NXCD; wgid = (xcd < r ? xcd * (q + 1) : r * (q + 1) + (xcd - r) * q) + off; }
        const int nig = WGM * nN, gid = wgid / nig, fm = gid * WGM, gsz = (nM - fm) < WGM ? (nM - fm) : WGM;
        u.pm = fm + ((wgid % nig) % gsz); u.pn = (wgid % nig) / gsz; return true;
    }
};
template <class Epi>
__device__ __forceinline__ void run_epi(const Epi& E, const f32x4 (&acc)[2][2][4][2], const Unit& u, int wr, int wc, int fr, int fq) {
    float rs[2][4];
#pragma unroll
    for (int ai = 0; ai < 2; ++ai)
#pragma unroll
        for (int m = 0; m < 4; ++m) rs[ai][m] = E.rowscale(u.pm * BM + ai * HALF + wr * 64 + m * 16 + fr);
#pragma unroll
    for (int ai = 0; ai < 2; ++ai)
#pragma unroll
        for (int m = 0; m < 4; ++m) {
            float lo[8], hi[8];
#pragma unroll
            for (int j = 0; j < 4; ++j) { lo[j] = acc[ai][0][m][0][j]; lo[4 + j] = acc[ai][0][m][1][j]; hi[j] = acc[ai][1][m][0][j]; hi[4 + j] = acc[ai][1][m][1][j]; }
            E.apply(u.pm * BM + ai * HALF + wr * 64 + m * 16 + fr, u.pn, wc * 32 + fq * 8, lo, hi, rs[ai][m]);
            if (m == 3) asm volatile("" ::: "memory");
        }
}
template <class Epi, class Sched, bool F8 = false>
__device__ __forceinline__ void gemm_phase(PG8_LAS unsigned char* lds, const Gemm g, const Sched& S, const Epi& E) {
    const int tid = threadIdx.x, wid = __builtin_amdgcn_readfirstlane(tid >> 6), lane = tid & 63, wr = wid >> 2, wc = wid & 3, fr = lane & 15, fq = lane >> 4;
    const int K = g.K, nt = K / BK;
    unsigned voffA[2], voffB[2];
#pragma unroll
    for (int i = 0; i < 2; ++i) { int R, C; stage_rc(tid * 16 + i * 8192, R, C); const int Rb = (R & ~31) + perm32(R & 31);
        voffA[i] = (unsigned)(R * g.lda + C) * 2u; voffB[i] = (unsigned)(Rb * g.ldb + C) * 2u; }
    const size_t kstep = (size_t)(BK * 2);
    const size_t hstepA = (size_t)HALF * g.lda * 2, hstepB = (size_t)HALF * g.ldb * 2;
    const size_t tstepA = 2 * hstepA, tstepB = 2 * hstepB;
    const unsigned ldsw = (unsigned)wid * 1024u;
    const int aoff = lds_byte(wr * 64 + fr, fq * 8), boff = lds_byte(wc * 32 + fr, fq * 8);
#define PG8_SA(b, h) (((b) * 2 + (h)) * HTB)
#define PG8_SB(b, h) ((4 + (b) * 2 + (h)) * HTB)
    const __amdgpu_buffer_rsrc_t rsA = __builtin_amdgcn_make_buffer_rsrc((void*)g.A, 0, 0x7fffffff, 0x00020000), rsB = __builtin_amdgcn_make_buffer_rsrc((void*)g.Bt, 0, 0x7fffffff, 0x00020000);
#define PG8_STAGE(bufoff, gbase, voff) do { const bool isA_ = ((voff) == voffA); const int so_ = (int)((const char*)(gbase) - (isA_ ? (const char*)g.A : (const char*)g.Bt)); \
        _Pragma("unroll") for (int _i = 0; _i < 2; ++_i) \
        __builtin_amdgcn_raw_ptr_buffer_load_lds(isA_ ? rsA : rsB, (PG8_LAS unsigned*)(lds + (bufoff) + ldsw + _i * 8192), 16, (int)(voff)[_i], so_, 0, 0); } while (0)
#define PG8_LD16(off) (*(const PG8_LAS v4i*)(lds + (off)))
#define PG8_LDA(dst, b, h) do { _Pragma("unroll") for (int m = 0; m < 4; ++m) { if constexpr (F8) dst##8[m] = __builtin_shufflevector(PG8_LD16(PG8_SA(b, h) + aoff + m * 2048), PG8_LD16(PG8_SA(b, h) + aoff + m * 2048 + 1024), 0, 1, 2, 3, 4, 5, 6, 7); \
        else { _Pragma("unroll") for (int k = 0; k < 2; ++k) dst[m][k] = *(const PG8_LAS bf16x8*)(lds + PG8_SA(b, h) + aoff + m * 2048 + k * 1024); } } } while (0)
#define PG8_LDB(dst, b, h) do { _Pragma("unroll") for (int n = 0; n < 2; ++n) { if constexpr (F8) dst##8[n] = __builtin_shufflevector(PG8_LD16(PG8_SB(b, h) + boff + n * 2048), PG8_LD16(PG8_SB(b, h) + boff + n * 2048 + 1024), 0, 1, 2, 3, 4, 5, 6, 7); \
        else { _Pragma("unroll") for (int k = 0; k < 2; ++k) dst[n][k] = *(const PG8_LAS bf16x8*)(lds + PG8_SB(b, h) + boff + n * 2048 + k * 1024); } } } while (0)
#define PG8_MMA(ai, bj, At, Bt) do { __builtin_amdgcn_s_setprio(1); _Pragma("unroll") for (int m = 0; m < 4; ++m) _Pragma("unroll") for (int n = 0; n < 2; ++n) { \
        if constexpr (F8) asm volatile("v_mfma_scale_f32_16x16x128_f8f6f4 %0, %1, %2, %0, %3, %3 op_sel_hi:[0,0,0]" : "+v"(acc[ai][bj][m][n]) : "v"(Bt##8[n]), "v"(At##8[m]), "v"(sc8));   \
        else { _Pragma("unroll") for (int k = 0; k < 2; ++k) acc[ai][bj][m][n] = __builtin_amdgcn_mfma_f32_16x16x32_bf16(Bt[n][k], At[m][k], acc[ai][bj][m][n], 0, 0, 0); } } \
        __builtin_amdgcn_s_setprio(0); } while (0)
#define PG8_WAIT_V(n) asm volatile("s_waitcnt vmcnt(" #n ")" ::: "memory")
#define PG8_WAIT_L(n) asm volatile("s_waitcnt lgkmcnt(" #n ")" ::: "memory")
#define PG8_BAR __builtin_amdgcn_s_barrier()
#define PG8_SCHED __builtin_amdgcn_sched_barrier(0)
    Unit cur, nxt; int ui = 0;
    if (!S.next(0, cur)) return;
    f32x4 acc[2][2][4][2];
#pragma unroll
    for (int a = 0; a < 2; ++a)
#pragma unroll
        for (int b = 0; b < 2; ++b)
#pragma unroll
            for (int m = 0; m < 4; ++m)
#pragma unroll
                for (int n = 0; n < 2; ++n) acc[a][b][m][n] = (f32x4){0.f, 0.f, 0.f, 0.f};
    const int sc8 = 0x7f7f7f7f; bf16x8 At[4][2], B0[2][2], B1[2][2]; v8i At8[4], B08[2], B18[2];
    const char* cA = (const char*)g.A + (size_t)cur.pm * tstepA; const char* cB = (const char*)g.Bt + (size_t)cur.pn * tstepB;
    PG8_STAGE(PG8_SB(0, 0), cB, voffB); PG8_STAGE(PG8_SA(0, 0), cA, voffA); PG8_STAGE(PG8_SB(0, 1), cB + hstepB, voffB); PG8_STAGE(PG8_SA(0, 1), cA + hstepA, voffA);
    if (wr == 1) PG8_BAR;
    PG8_WAIT_V(4); PG8_BAR;
    PG8_STAGE(PG8_SB(1, 0), cB + kstep, voffB); PG8_STAGE(PG8_SA(1, 0), cA + kstep, voffA); PG8_STAGE(PG8_SB(1, 1), cB + hstepB + kstep, voffB);
    PG8_WAIT_V(6); PG8_BAR;
    for (;;) {
        const bool has_next = S.next(ui + 1, nxt);
        const char* nA = has_next ? (const char*)g.A + (size_t)nxt.pm * tstepA : cA; const char* nB = has_next ? (const char*)g.Bt + (size_t)nxt.pn * tstepB : cB;
        for (int t = 0; t < nt; t += 2) {
            const bool last = (t == nt - 2);
            const char* a1 = cA + (size_t)(t + 1) * kstep;
            const char* a2 = last ? nA : cA + (size_t)(t + 2) * kstep; const char* b2 = last ? nB : cB + (size_t)(t + 2) * kstep;
            const char* a3 = a2 + kstep; const char* b3 = b2 + kstep;
            PG8_LDB(B0, 0, 0); PG8_SCHED; PG8_LDA(At, 0, 0); PG8_STAGE(PG8_SA(1, 1), a1 + hstepA, voffA);
            PG8_WAIT_L(8); PG8_BAR; PG8_WAIT_L(0); PG8_MMA(0, 0, At, B0); PG8_BAR; PG8_SCHED;
            PG8_LDB(B1, 0, 1); PG8_STAGE(PG8_SB(0, 0), b2, voffB);
            PG8_BAR; PG8_WAIT_L(0); PG8_MMA(0, 1, At, B1); PG8_BAR;
            PG8_LDA(At, 0, 1); PG8_STAGE(PG8_SA(0, 0), a2, voffA);
            PG8_BAR; PG8_WAIT_L(0); PG8_MMA(1, 0, At, B0); PG8_BAR; PG8_SCHED;
            PG8_STAGE(PG8_SB(0, 1), b2 + hstepB, voffB);
            PG8_WAIT_V(6); PG8_BAR; PG8_MMA(1, 1, At, B1); PG8_BAR;
            PG8_LDB(B0, 1, 0); PG8_SCHED; PG8_LDA(At, 1, 0); PG8_STAGE(PG8_SA(0, 1), a2 + hstepA, voffA);
            PG8_WAIT_L(8); PG8_BAR; PG8_WAIT_L(0); PG8_MMA(0, 0, At, B0); PG8_BAR; PG8_SCHED;
            PG8_LDB(B1, 1, 1); PG8_STAGE(PG8_SB(1, 0), b3, voffB);
            PG8_BAR; PG8_WAIT_L(0); PG8_MMA(0, 1, At, B1); PG8_BAR;
            PG8_LDA(At, 1, 1); PG8_STAGE(PG8_SA(1, 0), a3, voffA);
            PG8_BAR; PG8_WAIT_L(0); PG8_MMA(1, 0, At, B0); PG8_BAR; PG8_SCHED;
            PG8_STAGE(PG8_SB(1, 1), b3 + hstepB, voffB);
            PG8_WAIT_V(6); PG8_BAR; PG8_MMA(1, 1, At, B1); PG8_BAR;
        }
        if constexpr (F8) asm volatile("s_nop 15\n\ts_nop 15" ::: "memory");
        run_epi(E, acc, cur, wr, wc, fr, fq);
        if (!has_next) break;
#pragma unroll
        for (int a = 0; a < 2; ++a)
#pragma unroll
            for (int b = 0; b < 2; ++b)
#pragma unroll
                for (int m = 0; m < 4; ++m)
#pragma unroll
                    for (int n = 0; n < 2; ++n) acc[a][b][m][n] = (f32x4){0.f, 0.f, 0.f, 0.f};
        cur = nxt; cA = nA; cB = nB; ++ui;
    }
    PG8_WAIT_V(0);
    if (wr == 0) PG8_BAR;
    PG8_BAR;
#undef PG8_SA
#undef PG8_SB
#undef PG8_STAGE
#undef PG8_LDA
#undef PG8_LDB
#undef PG8_MMA
#undef PG8_LD16
#undef PG8_WAIT_V
#undef PG8_WAIT_L
#undef PG8_BAR
#undef PG8_SCHED
}
}

#define XB_TMO      128
#define XB_XCNT(j)  (256  + 64 * (j))
#define XB_XSUB(j)  (1280 + 64 * (j))
#define XB_XGEN(j)  (2304 + 64 * (j))
#define XB_TOP      3328
#define XB_TOPGEN   3392
#define XCD_BAR_WORDS 3456
#define XB_SPIN_CAP (1u << 20)
#define LAS __attribute__((address_space(3)))
__device__ __forceinline__ unsigned xb_ld(unsigned* p)              { return __hip_atomic_load(p, __ATOMIC_RELAXED, __HIP_MEMORY_SCOPE_AGENT); }
__device__ __forceinline__ unsigned xb_add(unsigned* p, unsigned v) { return __hip_atomic_fetch_add(p, v, __ATOMIC_RELAXED, __HIP_MEMORY_SCOPE_AGENT); }
__device__ __forceinline__ unsigned xb_xcc_id() { return (unsigned)__builtin_amdgcn_s_getreg((3 << 11) | 20) & 0xFu; }
#define XB_SPIN(cond, bar) do { unsigned _sp = 0; while (cond) { __builtin_amdgcn_s_sleep(1); \
    if ((++_sp & 255u) == 0u) { if (xb_ld(&(bar)[XB_TMO])) break; if (_sp > XB_SPIN_CAP) { atomicAdd(&(bar)[XB_TMO], 1u); break; } } } } while (0)
struct XcdBarrier { unsigned* bar; unsigned x; volatile LAS unsigned* st; };
__device__ __forceinline__ XcdBarrier xcd_barrier_post(unsigned* bar, volatile LAS unsigned* st) {
    XcdBarrier b; b.bar = bar; b.x = xb_xcc_id(); b.st = st;
    if (threadIdx.x == 0) (void)xb_add(&bar[XB_XCNT(b.x)], 1u);
    return b;
}
__device__ __forceinline__ void xcd_barrier_complete(unsigned* bar, unsigned x, unsigned& nloc, unsigned& nx) {
    const unsigned G = gridDim.x * gridDim.y * gridDim.z;
    unsigned sum, cnt, mine, sp = 0u;
    for (;;) {
        sum = 0u; cnt = 0u; mine = 0u;
#pragma unroll
        for (unsigned j = 0; j < 16; ++j) { const unsigned c = xb_ld(&bar[XB_XCNT(j)]); sum += c; cnt += (c > 0u) ? 1u : 0u; mine = (j == x) ? c : mine; }
        if (sum == G) break;
        __builtin_amdgcn_s_sleep(1);
        if ((++sp & 255u) == 0u) { if (xb_ld(&bar[XB_TMO])) break; if (sp > XB_SPIN_CAP) { atomicAdd(&bar[XB_TMO], 1u); break; } }
    }
    nloc = mine > 0u ? mine : 1u; nx = cnt > 0u ? cnt : 1u;
}
__device__ __forceinline__ void xcd_barrier(const XcdBarrier& b) {
    asm volatile("s_waitcnt vmcnt(0)" ::: "memory");
    __syncthreads();
    if (threadIdx.x == 0) {
        unsigned* bar = b.bar;
        __builtin_amdgcn_s_waitcnt(0);
        unsigned nloc = b.st[0], nx = b.st[1];
        if (nloc == 0u) { xcd_barrier_complete(bar, b.x, nloc, nx); b.st[0] = nloc; b.st[1] = nx; }
        const unsigned old = xb_add(&bar[XB_XSUB(b.x)], 1u);
        const unsigned gen = old / nloc;
        if (old + 1u == (gen + 1u) * nloc) {
            __builtin_amdgcn_fence(__ATOMIC_RELEASE, "agent");
            asm volatile("s_waitcnt vmcnt(0)" ::: "memory");
            const unsigned og = xb_add(&bar[XB_TOP], 1u);
            const unsigned tg = og / nx;
            if (og + 1u == (tg + 1u) * nx) xb_add(&bar[XB_TOPGEN], 1u);
            else XB_SPIN(xb_ld(&bar[XB_TOPGEN]) == tg, bar);
            __builtin_amdgcn_fence(__ATOMIC_ACQUIRE, "agent");
            xb_add(&bar[XB_XGEN(b.x)], 1u);
            asm volatile("s_waitcnt vmcnt(0)" ::: "memory");
        } else {
            XB_SPIN(xb_ld(&bar[XB_XGEN(b.x)]) == gen, bar);
            __builtin_amdgcn_fence(__ATOMIC_ACQUIRE, "agent");
            asm volatile("s_waitcnt vmcnt(0)" ::: "memory");
        }
    }
    __syncthreads();
}

template <bool XI16, bool XO16, bool HN8, bool R2E = false>
__device__ __forceinline__ void resnorm_rows(const void* xi_, const bf16_t* __restrict__ t, const float* __restrict__ part, const float* __restrict__ gpost, const float* __restrict__ gpre, void* xo_, bf16_t* hn, int bid, int nb, float* r2out = nullptr) {
    const int wid = threadIdx.x >> 6, lane = threadIdx.x & 63;
    for (int row = bid * 8 + wid; row < S; row += nb * 8) {
        const float ss = wave_sum(part[(size_t)row * 64 + lane]); const float r = rsqrtf(ss * (1.0f / DM) + EPS);
        float s2 = 0.f;
#pragma unroll 1
        for (int i0 = 0; i0 < 16; i0 += 8) {
            f32x4 xv[8]; u32x2 tw[8];
#pragma unroll
            for (int j = 0; j < 8; ++j) { const size_t e = (size_t)row * DM + (i0 + j) * 256 + lane * 4;
                if (XI16) { const u32x2 xw = *(const u32x2*)((const bf16_t*)xi_ + e); xv[j][0] = __uint_as_float(xw.x << 16); xv[j][1] = __uint_as_float(xw.x & 0xffff0000u); xv[j][2] = __uint_as_float(xw.y << 16); xv[j][3] = __uint_as_float(xw.y & 0xffff0000u); }
                else xv[j] = __builtin_nontemporal_load((const f32x4*)((const float*)xi_ + e));
                tw[j] = *(const u32x2*)(t + e); }
#pragma unroll
            for (int j = 0; j < 8; ++j) { const int col = (i0 + j) * 256 + lane * 4; const size_t e = (size_t)row * DM + col; const f32x4 gg = *(const f32x4*)(gpost + col);
                f32x4 o; o[0] = xv[j][0] + __uint_as_float(tw[j].x << 16) * r * gg[0]; o[1] = xv[j][1] + __uint_as_float(tw[j].x & 0xffff0000u) * r * gg[1];
                o[2] = xv[j][2] + __uint_as_float(tw[j].y << 16) * r * gg[2]; o[3] = xv[j][3] + __uint_as_float(tw[j].y & 0xffff0000u) * r * gg[3];
                s2 += o[0] * o[0] + o[1] * o[1] + o[2] * o[2] + o[3] * o[3];
                if (XO16) { u32x2 w; w.x = pk2(o[0], o[1]); w.y = pk2(o[2], o[3]); *(u32x2*)((bf16_t*)xo_ + e) = w; } else *(f32x4*)((float*)xo_ + e) = o;
                if (R2E) { const f32x4 gp = *(const f32x4*)(gpre + col); *(unsigned*)((unsigned char*)hn + (size_t)row * LD8 + col) = pk4_fp8(o[0] * gp[0], o[1] * gp[1], o[2] * gp[2], o[3] * gp[3]); } }
        }
        if (R2E) { s2 = wave_sum(s2); if (lane == 0) r2out[row] = rsqrtf(s2 * (1.0f / DM) + EPS); continue; }
        if (hn) { s2 = wave_sum(s2); const float r2 = rsqrtf(s2 * (1.0f / DM) + EPS);
#pragma unroll 1
            for (int i0 = 0; i0 < 16; i0 += 8) {
                f32x4 v[8];
#pragma unroll
                for (int j = 0; j < 8; ++j) { const size_t e = (size_t)row * DM + (i0 + j) * 256 + lane * 4;
                    if (XO16) { const u32x2 xw = *(const u32x2*)((const bf16_t*)xo_ + e); v[j][0] = __uint_as_float(xw.x << 16); v[j][1] = __uint_as_float(xw.x & 0xffff0000u); v[j][2] = __uint_as_float(xw.y << 16); v[j][3] = __uint_as_float(xw.y & 0xffff0000u); }
                    else v[j] = *(const f32x4*)((const float*)xo_ + e); }
#pragma unroll
                for (int j = 0; j < 8; ++j) { const int col = (i0 + j) * 256 + lane * 4; const f32x4 gg = *(const f32x4*)(gpre + col);
                    if (HN8) *(unsigned*)((unsigned char*)hn + (size_t)row * LD8 + col) = pk4_fp8(v[j][0] * r2 * gg[0], v[j][1] * r2 * gg[1], v[j][2] * r2 * gg[2], v[j][3] * r2 * gg[3]);
                    else { u32x2 w; w.x = pk2(v[j][0] * r2 * gg[0], v[j][1] * r2 * gg[1]); w.y = pk2(v[j][2] * r2 * gg[2], v[j][3] * r2 * gg[3]); *(u32x2*)(hn + (size_t)row * LDK + col) = w; } }
            } }
    }
}

namespace at {
typedef short s16x4 __attribute__((ext_vector_type(4)));
typedef float f32x16 __attribute__((ext_vector_type(16)));
constexpr int SHM_T = 64 * 128 * 2;
constexpr int OFF_V = 0, OFF_K = 3 * SHM_T, OFF_WS = 6 * SHM_T;
constexpr int OFF_IMP = OFF_WS + 2048, IMP_LD = 129, OFF_SEL = OFF_IMP + 64 * IMP_LD * 4, OFF_END = OFF_SEL + 1024;
static_assert(OFF_END <= 136 * 1024, "attention LDS");
constexpr float THR = 8.f;
constexpr float C2 = 1.4426950408889634f * QSCALE;
constexpr unsigned WHUGE = 0x7fffffffu;
#define KSWZ(row, colB) ((row) * 256 + ((colB) ^ (((row) & 7) << 4)))
#define SBAR() __builtin_amdgcn_sched_barrier(0)
__device__ __forceinline__ int v_st(int k, int c) { const int kk = (k & ~0xC) | ((k & 4) << 1) | ((k & 8) >> 1); return ((kk >> 3) * 4 + (c >> 5)) * 512 + ((kk & 7) * 32 + (c & 31)) * 2; }
__device__ __forceinline__ int v_rd_base(int lane) { return ((lane & 3) << 3) | (((lane >> 2) & 3) << 6) | (((lane >> 4) & 1) << 5) | (((lane >> 5) & 1) << 8); }
constexpr int v_rd_off(int d0, int ks, int half) { return d0 * 512 + ks * 4096 + half * 2048; }
__device__ __forceinline__ int crow(int r, int hi) { return (r & 3) + 8 * (r >> 2) + 4 * hi; }
__device__ __forceinline__ unsigned cvtpk(float lo, float hi) { unsigned r; asm volatile("v_cvt_pk_bf16_f32 %0, %1, %2" : "=v"(r) : "v"(lo), "v"(hi)); return r; }
__device__ __forceinline__ void mask_tile(f32x16& p0, f32x16& p1, int dq, unsigned W) {
    const float NEG = -__builtin_inff();
#pragma unroll
    for (int r = 0; r < 16; ++r) { const int c = (r & 3) + 8 * (r >> 2); if ((unsigned)(dq - c) >= W) p0[r] = NEG; if ((unsigned)(dq - c - 32) >= W) p1[r] = NEG; }
}
__device__ __forceinline__ void partialSM(f32x16& p0, f32x16& p1, float& m_reg, float& alpha, bool rowok) {
    float pmax = p0[0];
#pragma unroll
    for (int r = 1; r < 16; ++r) pmax = fmaxf(pmax, p0[r]);
#pragma unroll
    for (int r = 0; r < 16; ++r) pmax = fmaxf(pmax, p1[r]);
    { auto rr = __builtin_amdgcn_permlane32_swap(__float_as_uint(pmax), __float_as_uint(pmax), false, false); pmax = fmaxf(__uint_as_float(rr[0]), __uint_as_float(rr[1])); }
    pmax = rowok ? pmax : -__builtin_inff();
    float mn;
    if (__builtin_expect(__all((pmax - m_reg) * QSCALE <= THR), 1)) { mn = m_reg; alpha = 1.f; }
    else { mn = fmaxf(m_reg, pmax); alpha = __builtin_amdgcn_exp2f((m_reg - mn) * C2); m_reg = mn; }
    const float mnL = rowok ? -mn * C2 : -__builtin_inff();
#pragma unroll
    for (int r = 0; r < 16; ++r) { p0[r] = __builtin_amdgcn_exp2f(fmaf(p0[r], C2, mnL)); p1[r] = __builtin_amdgcn_exp2f(fmaf(p1[r], C2, mnL)); }
}
__device__ __forceinline__ void packP(const f32x16& p0, const f32x16& p1, bf16x8& pa0, bf16x8& pa1, bf16x8& pa2, bf16x8& pa3) {
#define PK4(P, B_, OUT) do { unsigned a0 = cvtpk(P[B_+0], P[B_+1]), a1 = cvtpk(P[B_+2], P[B_+3]); unsigned b0 = cvtpk(P[B_+4], P[B_+5]), b1 = cvtpk(P[B_+6], P[B_+7]); \
        auto r0 = __builtin_amdgcn_permlane32_swap(a0, b0, false, false); auto r1 = __builtin_amdgcn_permlane32_swap(a1, b1, false, false); \
        u32x4 w = {r0[0], r1[0], r0[1], r1[1]}; OUT = *reinterpret_cast<bf16x8*>(&w); } while (0)
    PK4(p0, 0, pa0); PK4(p0, 8, pa1); PK4(p1, 0, pa2); PK4(p1, 8, pa3);
#undef PK4
}
__device__ __forceinline__ float rowsum(const f32x16& p0, const f32x16& p1) {
    float ps = 0.f;
#pragma unroll
    for (int r = 0; r < 16; ++r) ps += p0[r] + p1[r];
    auto rr = __builtin_amdgcn_permlane32_swap(__float_as_uint(ps), __float_as_uint(ps), false, false); return __uint_as_float(rr[0]) + __uint_as_float(rr[1]);
}
__device__ __forceinline__ void qkt(f32x16& p0, f32x16& p1, PG8_LAS const unsigned char* lds, int kboff, int r32, int hi, const bf16x8 (&qr)[8], bool act) {
    if (!act) { const float NEG = -__builtin_inff();
#pragma unroll
        for (int r = 0; r < 16; ++r) { p0[r] = NEG; p1[r] = NEG; } return; }
    const f32x16 z = {0.f, 0.f, 0.f, 0.f, 0.f, 0.f, 0.f, 0.f, 0.f, 0.f, 0.f, 0.f, 0.f, 0.f, 0.f, 0.f};
    const int kb_ = (int)(uintptr_t)lds + kboff;
    const int a0 = kb_ + KSWZ(r32, (0 * 16 + hi * 8) * 2), a1 = kb_ + KSWZ(r32, (1 * 16 + hi * 8) * 2), a2 = kb_ + KSWZ(r32, (2 * 16 + hi * 8) * 2), a3 = kb_ + KSWZ(r32, (3 * 16 + hi * 8) * 2);
#define KRD(dst, addr, off) asm volatile("ds_read_b128 %0, %1 offset:%2" : "=&v"(dst) : "v"(addr), "i"(OFF_K + (off)) : "memory")
#define KWAIT(n) do { asm volatile("s_waitcnt lgkmcnt(" #n ")" ::: "memory"); SBAR(); } while (0)
#define KMM(x0, x1, d0) do { p0 = __builtin_amdgcn_mfma_f32_32x32x16_bf16(x0, qr[d0], p0, 0, 0, 0); p1 = __builtin_amdgcn_mfma_f32_32x32x16_bf16(x1, qr[d0], p1, 0, 0, 0); } while (0)
    bf16x8 k0, k1, k2, k3, k4, k5, k6, k7;
    KRD(k0, a0, 0); KRD(k1, a0, 8192); KRD(k2, a1, 0); KRD(k3, a1, 8192); KRD(k4, a2, 0); KRD(k5, a2, 8192); KRD(k6, a3, 0); KRD(k7, a3, 8192);
    KWAIT(6); p0 = __builtin_amdgcn_mfma_f32_32x32x16_bf16(k0, qr[0], z, 0, 0, 0); p1 = __builtin_amdgcn_mfma_f32_32x32x16_bf16(k1, qr[0], z, 0, 0, 0); SBAR(); KRD(k0, a0, 128); KRD(k1, a0, 128 + 8192);
    KWAIT(6); KMM(k2, k3, 1); SBAR(); KRD(k2, a1, 128); KRD(k3, a1, 128 + 8192);
    KWAIT(6); KMM(k4, k5, 2); SBAR(); KRD(k4, a2, 128); KRD(k5, a2, 128 + 8192);
    KWAIT(6); KMM(k6, k7, 3); SBAR(); KRD(k6, a3, 128); KRD(k7, a3, 128 + 8192);
    KWAIT(6); KMM(k0, k1, 4);
    KWAIT(4); KMM(k2, k3, 5);
    KWAIT(2); KMM(k4, k5, 6);
    KWAIT(0); KMM(k6, k7, 7);
#undef KMM
#undef KWAIT
#undef KRD
}
__device__ __forceinline__ void pv_tile(f32x16 (&o)[4], int vb0  , bf16x8 pa0, bf16x8 pa1, bf16x8 pa2, bf16x8 pa3, bool act) {
    if (!act) return;
#define TRRD(dst, off) asm volatile("ds_read_b64_tr_b16 %0, %1 offset:%2" : "=&v"(dst) : "v"(vb0), "i"(off) : "memory")
#define PV_D0(d0) do { s16x4 l0, l1, l2, l3, h0, h1, h2, h3; constexpr int b_ = v_rd_off(d0, 0, 0); \
        TRRD(l0, b_); TRRD(h0, b_ + 2048); TRRD(l1, b_ + 4096); TRRD(h1, b_ + 6144); TRRD(l2, b_ + 8192); TRRD(h2, b_ + 10240); TRRD(l3, b_ + 12288); TRRD(h3, b_ + 14336); \
        asm volatile("s_waitcnt lgkmcnt(0)" ::: "memory"); SBAR(); \
        o[d0] = __builtin_amdgcn_mfma_f32_32x32x16_bf16(pa0, (bf16x8){l0[0], l0[1], l0[2], l0[3], h0[0], h0[1], h0[2], h0[3]}, o[d0], 0, 0, 0); \
        o[d0] = __builtin_amdgcn_mfma_f32_32x32x16_bf16(pa1, (bf16x8){l1[0], l1[1], l1[2], l1[3], h1[0], h1[1], h1[2], h1[3]}, o[d0], 0, 0, 0); \
        o[d0] = __builtin_amdgcn_mfma_f32_32x32x16_bf16(pa2, (bf16x8){l2[0], l2[1], l2[2], l2[3], h2[0], h2[1], h2[2], h2[3]}, o[d0], 0, 0, 0); \
        o[d0] = __builtin_amdgcn_mfma_f32_32x32x16_bf16(pa3, (bf16x8){l3[0], l3[1], l3[2], l3[3], h3[0], h3[1], h3[2], h3[3]}, o[d0], 0, 0, 0); } while (0)
    PV_D0(0); PV_D0(1); PV_D0(2); PV_D0(3);
#undef PV_D0
#undef TRRD
}

__device__ __forceinline__ void lds_add(PG8_LAS unsigned* p, unsigned v) { (void)__hip_atomic_fetch_add(p, v, __ATOMIC_RELAXED, __HIP_MEMORY_SCOPE_WORKGROUP); }
struct KV { const bf16_t* K; const bf16_t* V; int ks, vs; };
struct PolWin {
    int qmin, qmax, Wn;
    __device__ __forceinline__ void tile(int, int kb, unsigned& W, bool& act, bool& need, bool& rowok) const {
        rowok = true; W = (unsigned)Wn; act = (kb <= qmax) && (kb + 63 >= qmin - Wn + 1); need = !((kb + 63 <= qmin) && (kb >= qmax - Wn + 1)); }
};
struct PolCmp {
    int lmin, lmax;
    __device__ __forceinline__ void tile(int, int kb, unsigned& W, bool& act, bool& need, bool& rowok) const { rowok = true; W = WHUGE; act = kb <= lmax; need = kb + 63 > lmin; }
};
struct PolSel {
    PG8_LAS const unsigned* selrow; int cur;
    __device__ __forceinline__ void tile(int t, int, unsigned& W, bool& act, bool& need, bool& rowok) const {
        const bool bit = (selrow[t >> 5] >> (t & 31)) & 1u; rowok = bit; W = WHUGE; act = __ballot(bit) != 0ull; need = (t == cur); }
};

struct BgNone {
    __device__ __forceinline__ bool want() const { return false; }
    __device__ __forceinline__ bool pending() const { return false; }
    __device__ __forceinline__ void issue(int) {}
    __device__ __forceinline__ void commit(int) {}
};
struct BgConvGU {
    const float* W0; unsigned char* Bt0; const float* W1; unsigned char* Bt1; const float* W2; const float* W3; unsigned char* Bt2; PG8_LAS unsigned char* wl; int gw, n_total, si; bool pend;
    static constexpr int TK0 = DM / 64, TK1 = (DFF / 2) / 64, TK2 = 512 / 64, TK3 = 2048 / 64;
    static constexpr int B1 = (NGU / 64) * TK0, B2 = B1 + (DM / 64) * TK1, B3 = B2 + (DM / 64) * TK2, B4 = B3 + (DM / 64) * TK3;
    struct Sl { const float* W; unsigned char* dst; size_t ldw; int n0; bool f8, gu; };
    __device__ __forceinline__ void init(const float* w_gu, unsigned char* gut, const float* w_down, unsigned char* wdt, const float* w_a, const float* w_b, unsigned char* wabt,
                                         PG8_LAS unsigned char* wl_, int gw_, bool on) {
        W0 = w_gu; Bt0 = gut; W1 = w_down; Bt1 = wdt; W2 = w_a; W3 = w_b; Bt2 = wabt; wl = wl_; gw = gw_; si = 0; pend = false;
        n_total = (on && gw_ < B4) ? 4 * ((B4 - gw_ + 2047) / 2048) : 0; }
    __device__ __forceinline__ bool want() const { return !pend && si < n_total; }
    __device__ __forceinline__ bool pending() const { return pend; }
#define BG_LOC(Ip, TK) const int nn_ = (((Ip) / (4 * (TK))) * 4 + ((Ip) & 3)) * 64, kk_ = (((Ip) >> 2) % (TK)) * 64 + 16 * (si & 3)
    __device__ __forceinline__ void decode(int lane_n, Sl& r, const float*& src) const {
        const int I = gw + (si >> 2) * 2048;
        if (I < B1) { BG_LOC(I, TK0); r = Sl{W0, Bt0 + (size_t)nn_ * LD8 + kk_, (size_t)NGU, nn_, true, true}; src = W0 + (size_t)kk_ * NGU + MapGU()(nn_ + lane_n); }
        else if (I < B2) { BG_LOC(I - B1, TK1); r = Sl{W1, Bt1 + (size_t)nn_ * LDA8 + kk_, (size_t)DM, nn_, true, false}; src = W1 + (size_t)kk_ * DM + nn_ + lane_n; }
        else if (I < B3) { BG_LOC(I - B2, TK2); r = Sl{W2, Bt2 + ((size_t)nn_ * KAB + kk_) * 2, (size_t)DM, nn_, false, false}; src = W2 + (size_t)kk_ * DM + nn_ + lane_n; }
        else { BG_LOC(I - B3, TK3); r = Sl{W3, Bt2 + ((size_t)nn_ * KAB + 512 + kk_) * 2, (size_t)DM, nn_, false, false}; src = W3 + (size_t)kk_ * DM + nn_ + lane_n; }
    }
#undef BG_LOC
    __device__ __forceinline__ void issue(int lane) {
        Sl r; const float* p; decode(4 * (lane & 15), r, p); p += (size_t)(lane >> 4) * r.ldw;
        const __amdgpu_buffer_rsrc_t rs = __builtin_amdgcn_make_buffer_rsrc((void*)r.W, 0, 0x7fffffff, 0x00020000);
        const int vo = (int)((const char*)p - (const char*)r.W), rstep = (int)r.ldw * 16;
#pragma unroll
        for (int i = 0; i < 4; ++i) __builtin_amdgcn_raw_ptr_buffer_load_lds(rs, (PG8_LAS unsigned*)(wl + i * 1024), 16, vo, i * rstep, 0, 2);
        pend = true;
    }
    __device__ __forceinline__ void commit(int lane) {
        float v[16];
#pragma unroll
        for (int kk = 0; kk < 16; ++kk) v[kk] = *(PG8_LAS const float*)(wl + kk * 256 + lane * 4);
        Sl r; const float* p; decode(0, r, p);
        if (r.f8) {
#pragma unroll
            for (int kk = 0; kk < 16; ++kk) v[kk] *= W8SCALE;
            u32x4 w; w.x = pk4_fp8(v[0], v[1], v[2], v[3]); w.y = pk4_fp8(v[4], v[5], v[6], v[7]); w.z = pk4_fp8(v[8], v[9], v[10], v[11]); w.w = pk4_fp8(v[12], v[13], v[14], v[15]);
            *(u32x4*)(r.dst + (size_t)lane * (r.gu ? LD8 : LDA8)) = w;
        } else {
            u32x4 w0, w1; w0.x = pk2(v[0], v[1]); w0.y = pk2(v[2], v[3]); w0.z = pk2(v[4], v[5]); w0.w = pk2(v[6], v[7]); w1.x = pk2(v[8], v[9]); w1.y = pk2(v[10], v[11]); w1.z = pk2(v[12], v[13]); w1.w = pk2(v[14], v[15]);
            unsigned char* d = r.dst + (size_t)lane * (KAB * 2); *(u32x4*)d = w0; *(u32x4*)(d + 16) = w1;
        }
        ++si; pend = false;
    }
};

template <int MODE, class Pol, class BG>
__device__ __forceinline__ void flash_loop(const Pol& pol, PG8_LAS unsigned char* lds, const KV kv, int j_lo, int nt, const bf16x8 (&qr)[8], int dq_base,
                                           f32x16 (&o)[4], float& m_reg, float& l_reg, float inv_l, PG8_LAS unsigned* improw, BG& bg) {
    int tid = threadIdx.x; asm volatile("" : "+v"(tid));
    const int wid = __builtin_amdgcn_readfirstlane(tid >> 6), lane = tid & 63, r32 = lane & 31, hi = lane >> 5;
    PG8_LAS float* al_l = (PG8_LAS float*)(lds + OFF_WS) + wid * 64 + 32;
    const int vb0 = (int)(uintptr_t)(lds + OFF_V) + v_rd_base(lane);
    unsigned offK[2], offV[2];
#pragma unroll
    for (int i = 0; i < 2; ++i) { const int b = tid * 16 + i * 8192;
        { const int row = b >> 8, colB = (b & 255) ^ ((row & 7) << 4); offK[i] = (unsigned)(row * kv.ks + (colB >> 1)) * 2u; }
        { const int sub = b >> 9, w = (b & 511) >> 1, kk = (sub >> 2) * 8 + (w >> 5), cc = (sub & 3) * 32 + (w & 31), k = (kk & ~0xC) | ((kk & 4) << 1) | ((kk & 8) >> 1); offV[i] = (unsigned)(k * kv.vs + cc) * 2u; } }
    const unsigned ldsw = (unsigned)wid * 1024u;
#define SLOAD(t_) SLOAD2(t_, t_)
    const __amdgpu_buffer_rsrc_t rsK = __builtin_amdgcn_make_buffer_rsrc((void*)kv.K, 0, 0x7fffffff, 0x00020000), rsV = __builtin_amdgcn_make_buffer_rsrc((void*)kv.V, 0, 0x7fffffff, 0x00020000);
#define SLOAD2(t_, sl_) do { const int so_k__ = (j_lo + (t_)) * 64 * kv.ks * 2, so_v__ = (j_lo + (t_)) * 64 * kv.vs * 2; \
        const int bo__ = (sl_) * SHM_T; \
        _Pragma("unroll") for (int i_ = 0; i_ < 2; ++i_) { \
            __builtin_amdgcn_raw_ptr_buffer_load_lds(rsK, (PG8_LAS unsigned*)(lds + OFF_K + bo__ + ldsw + i_ * 8192), 16, (int)offK[i_], so_k__, 0, 0); \
            if (MODE != 1) __builtin_amdgcn_raw_ptr_buffer_load_lds(rsV, (PG8_LAS unsigned*)(lds + OFF_V + bo__ + ldsw + i_ * 8192), 16, (int)offV[i_], so_v__, 0, 0); } } while (0)
#define WAIT_BUT_ONE() do { if (MODE == 1) asm volatile("s_waitcnt vmcnt(2)" ::: "memory"); else asm volatile("s_waitcnt vmcnt(4)" ::: "memory"); } while (0)
#define RAW_BAR() do { if (MODE != 2) { SBAR(); asm volatile("s_waitcnt lgkmcnt(0)" ::: "memory"); __builtin_amdgcn_s_barrier(); asm volatile("" ::: "memory"); SBAR(); } else __syncthreads(); } while (0)
    bf16x8 pa0, pa1, pa2, pa3;
    if (wid >= 4) __builtin_amdgcn_s_setprio(1);
    __syncthreads();
    SLOAD(0);
    if (nt > 1) { SLOAD(1); WAIT_BUT_ONE(); } else asm volatile("s_waitcnt vmcnt(0)" ::: "memory");
    RAW_BAR();
    int slot = 0;
    for (int t = 0; t < nt; ++t) {
        const int kb_ = (j_lo + t) * 64; unsigned W_; bool act_, need_, rowok_; pol.tile(t, kb_, W_, act_, need_, rowok_);
        if (t + 2 < nt) SLOAD2(t + 2, slot == 0 ? 2 : slot - 1);
        const bool bgi = bg.want(); if (bgi) bg.issue(lane);
        SBAR();
        if (MODE == 2 || act_) {
        f32x16 p0, p1; qkt(p0, p1, lds, slot * SHM_T, r32, hi, qr, act_);
        if (act_ && need_) mask_tile(p0, p1, dq_base - kb_, W_);
        if (MODE == 2) { const float mnL = -m_reg * C2;
#pragma unroll
            for (int r = 0; r < 16; ++r) { p0[r] = __builtin_amdgcn_exp2f(fmaf(p0[r], C2, mnL)) * inv_l; p1[r] = __builtin_amdgcn_exp2f(fmaf(p1[r], C2, mnL)) * inv_l; }
            if (act_) {
#pragma unroll
                for (int q4 = 0; q4 < 4; ++q4) { const int mblk = (kb_ >> 2) + 2 * q4 + hi;
                    float vm0 = p0[4 * q4] + p0[4 * q4 + 1] + p0[4 * q4 + 2] + 0.5f * p0[4 * q4 + 3], vn0 = 0.5f * p0[4 * q4 + 3];
                    float vm1 = p1[4 * q4] + p1[4 * q4 + 1] + p1[4 * q4 + 2] + 0.5f * p1[4 * q4 + 3], vn1 = 0.5f * p1[4 * q4 + 3];
                    vm0 += __shfl_xor(vm0, 1); vn0 += __shfl_xor(vn0, 1); vm1 += __shfl_xor(vm1, 1); vn1 += __shfl_xor(vn1, 1);
                    vm0 += __shfl_xor(vm0, 2); vn0 += __shfl_xor(vn0, 2); vm1 += __shfl_xor(vm1, 2); vn1 += __shfl_xor(vn1, 2);
                    if ((r32 & 3) == 0) {
                        lds_add(improw + mblk, (unsigned)(vm0 * 268435456.0f + 0.5f)); if (mblk + 1 < 128) lds_add(improw + mblk + 1, (unsigned)(vn0 * 268435456.0f + 0.5f));
                        lds_add(improw + mblk + 8, (unsigned)(vm1 * 268435456.0f + 0.5f)); if (mblk + 9 < 128) lds_add(improw + mblk + 9, (unsigned)(vn1 * 268435456.0f + 0.5f)); } } }
            packP(p0, p1, pa0, pa1, pa2, pa3);
        } else { float alpha; partialSM(p0, p1, m_reg, alpha, rowok_); l_reg = l_reg * alpha + rowsum(p0, p1);
            if (MODE == 0) { if (__any(alpha < 1.f)) { if (hi == 0) al_l[r32] = alpha; asm volatile("s_waitcnt lgkmcnt(0)" ::: "memory");
#pragma unroll
                    for (int d_ = 0; d_ < 4; ++d_)
#pragma unroll
                        for (int r = 0; r < 16; ++r) o[d_][r] *= al_l[crow(r, hi)]; }
                packP(p0, p1, pa0, pa1, pa2, pa3); } }
        if (MODE != 1) { SBAR(); pv_tile(o, vb0 + slot * SHM_T, pa0, pa1, pa2, pa3, act_); }
        }
        if (t + 2 < nt) { if (bgi) asm volatile("s_waitcnt vmcnt(8)" ::: "memory"); else WAIT_BUT_ONE(); } else { if (bgi) asm volatile("s_waitcnt vmcnt(4)" ::: "memory"); else asm volatile("s_waitcnt vmcnt(0)" ::: "memory"); }
        if (!bgi && bg.pending()) { SBAR(); bg.commit(lane); }
        RAW_BAR(); slot = slot == 2 ? 0 : slot + 1;
    }
    if (bg.pending()) { asm volatile("s_waitcnt vmcnt(0)" ::: "memory"); bg.commit(lane); }
    if (wid >= 4) __builtin_amdgcn_s_setprio(0);
#undef WAIT_BUT_ONE
#undef RAW_BAR
#undef SLOAD
#undef SLOAD2
}

template <bool ACCUM, class RowPtr>
__device__ __forceinline__ void store_o(PG8_LAS unsigned char* lds, const f32x16 (&o)[4], float f_row, const RowPtr& rp) {
    int tid = threadIdx.x; asm volatile("" : "+v"(tid));
    const int wid = __builtin_amdgcn_readfirstlane(tid >> 6), lane = tid & 63, r32 = lane & 31, hi = lane >> 5, odd = r32 & 1;
    PG8_LAS float* li_l = (PG8_LAS float*)(lds + OFF_WS) + wid * 64;
    if (hi == 0) li_l[r32] = f_row; asm volatile("s_waitcnt lgkmcnt(0)" ::: "memory");
    constexpr int RS = 272;
    PG8_LAS unsigned char* st = lds + OFF_V + wid * (32 * RS);
#pragma unroll
    for (int k = 0; k < 8; ++k) { const float f0 = li_l[crow(2 * k, hi)], f1 = li_l[crow(2 * k + 1, hi)]; const int row = crow(2 * k + odd, hi);
#pragma unroll
        for (int d0 = 0; d0 < 4; ++d0) { const float v0 = o[d0][2 * k] * f0, v1 = o[d0][2 * k + 1] * f1;
            const float rc = __shfl_xor(odd ? v0 : v1, 1);
            const float a = odd ? rc : v0, b = odd ? v1 : rc;
            *(PG8_LAS unsigned*)(st + row * RS + (d0 * 32 + (r32 & ~1)) * 2) = cvtpk(a, b); } }
    asm volatile("s_waitcnt lgkmcnt(0)" ::: "memory");
    bf16_t* gp[8]; u32x4 old[8];
#pragma unroll
    for (int i = 0; i < 8; ++i) { const int id = i * 64 + lane; gp[i] = rp(id >> 4) + (id & 15) * 8; if (ACCUM) old[i] = *(const u32x4*)gp[i]; }
#pragma unroll
    for (int i = 0; i < 8; ++i) { const int id = i * 64 + lane; u32x4 w = *(PG8_LAS const u32x4*)(st + (id >> 4) * RS + (id & 15) * 16);
        if (ACCUM) { float x[8], y[8]; unpack8(w, x); unpack8(old[i], y);
#pragma unroll
            for (int j = 0; j < 8; ++j) x[j] += y[j];
            w = pack8(x); }
        *(u32x4*)gp[i] = w; }
}
}

constexpr size_t WS_ODIL = WS_MG;
constexpr size_t WS_LDIL = WS_MX;
__device__ __forceinline__ void dilated_unit(const Ctx& c, PG8_LAS unsigned char* lds, int u) {
    using namespace at;
    const int tid = threadIdx.x, wid = __builtin_amdgcn_readfirstlane(tid >> 6), lane = tid & 63, r32 = lane & 31, hi = lane >> 5;
    const int g = u >> 7, v = u & 127, h = v & 3, w = v >> 2;
    const int rate = g == 0 ? 1 : (g == 1 ? 4 : 16), nblk = (S / rate) / 256, cls = w / nblk, blk = w % nblk;
    const int I0 = blk * 256, qmin = I0 + wid * 32, qi = qmin + r32;
    const size_t colo = (size_t)g * 512 + h * 128;
    const bf16_t* Q = WSP(bf16_t, WS_QA) + (size_t)(cls + rate * qi) * 1536 + colo;
    bf16x8 qr[8];
#pragma unroll
    for (int d0 = 0; d0 < 8; ++d0) qr[d0] = *(const bf16x8*)(Q + d0 * 16 + hi * 8);
    KV kv{WSP(bf16_t, WS_KA) + (size_t)cls * 1536 + colo, WSP(bf16_t, WS_VA) + (size_t)cls * 1536 + colo, rate * 1536, rate * 1536};
    const int j_lo = (I0 - 128 > 0 ? I0 - 128 : 0) / 64, nt = (I0 + 255) / 64 + 1 - j_lo;
    f32x16 o[4];
#pragma unroll
    for (int d = 0; d < 4; ++d)
#pragma unroll
        for (int r = 0; r < 16; ++r) o[d][r] = 0.f;
    float m_reg = -1e30f, l_reg = 0.f;
    PolWin pol{qmin, qmin + 31, 129};
    BgNone nobg; flash_loop<0>(pol, lds, kv, j_lo, nt, qr, qi - 4 * hi, o, m_reg, l_reg, 0.f, nullptr, nobg);
    bf16_t* od = WSP(bf16_t, WS_ODIL) + (size_t)g * S * 512 + h * 128;
    const int p0 = cls + rate * qmin;
    store_o<false>(lds, o, 1.0f / l_reg, [&](int orow) { return od + (size_t)(p0 + rate * orow) * 512; });
    if (hi == 0) WSP(float, WS_LDIL)[((size_t)g * S + (cls + rate * qi)) * 4 + h] = m_reg * QSCALE + __logf(l_reg);
}
__device__ __forceinline__ void dilated_combine(const Ctx& c, int bid, int nb) {
    const int tid = threadIdx.x, stride = nb * 512;
    for (int i0 = bid * 512 + tid; i0 < S * 64; i0 += 4 * stride) {
        float l0[4], l1[4], l2[4]; u32x4 va[4], vb[4], vd[4];
#pragma unroll
        for (int q = 0; q < 4; ++q) { const int i = i0 + q * stride; if (i < S * 64) { const int pos = i >> 6, c8 = (i & 63) * 8, h = c8 >> 7;
            const float* L = WSP(float, WS_LDIL) + (size_t)pos * 4 + h; l0[q] = L[0]; l1[q] = L[(size_t)S * 4]; l2[q] = L[(size_t)2 * S * 4];
            const bf16_t* od = WSP(bf16_t, WS_ODIL) + (size_t)pos * 512 + c8; va[q] = *(const u32x4*)od; vb[q] = *(const u32x4*)(od + (size_t)S * 512); vd[q] = *(const u32x4*)(od + (size_t)2 * S * 512); } }
#pragma unroll
        for (int q = 0; q < 4; ++q) { const int i = i0 + q * stride; if (i < S * 64) { const int pos = i >> 6, c8 = (i & 63) * 8;
            const float mx = fmaxf(l0[q], fmaxf(l1[q], l2[q])); const float e0 = __expf(l0[q] - mx), e1 = __expf(l1[q] - mx), e2 = __expf(l2[q] - mx), inv = 1.0f / (e0 + e1 + e2);
            float a[8], b[8], d[8], r[8]; unpack8(va[q], a); unpack8(vb[q], b); unpack8(vd[q], d);
#pragma unroll
            for (int j = 0; j < 8; ++j) r[j] = (e0 * a[j] + e1 * b[j] + e2 * d[j]) * inv;
            *(u32x4*)(WSP(bf16_t, WS_YC) + (size_t)pos * KAB + c8) = pack8(r); } }
    }
}

__device__ __forceinline__ float gelu_tanh_f(float x) { const float u = 0.7978845608028654f * (x + 0.044715f * x * x * x); const float e = __expf(2.0f * u); return 0.5f * x * (1.0f + (1.0f - 2.0f / (e + 1.0f))); }
__device__ __forceinline__ void compress_unit(const Ctx& c, PG8_LAS unsigned char* lds, int u) {
    const int tid = threadIdx.x, wid = __builtin_amdgcn_readfirstlane(tid >> 6), lane = tid & 63, fr = lane & 15, fq = lane >> 4;
    const int which = u >> 7, g = (u >> 5) & 3, n0 = (u & 31) * 16;
    const bf16_t* src = WSP(bf16_t, which ? WS_VC : WS_KC) + g * 128; const bf16_t* w1t = WSP(bf16_t, which ? WS_WCV1T : WS_WCK1T);
    int nrow = n0 + fr; if (nrow > NC - 1) nrow = NC - 1;
    f32x4 acc[8];
#pragma unroll
    for (int i = 0; i < 8; ++i) acc[i] = (f32x4){0.f, 0.f, 0.f, 0.f};
#pragma unroll 4
    for (int kk = 0; kk < 16; ++kk) { const int k = wid * 512 + kk * 32 + fq * 8, l = k >> 7, d = k & 127;
        const bf16x8 a = *(const bf16x8*)(src + (size_t)(16 * nrow + l) * 512 + d);
#pragma unroll
        for (int cs = 0; cs < 8; ++cs) { const bf16x8 b = *(const bf16x8*)(w1t + (size_t)(cs * 16 + fr) * 4096 + k); acc[cs] = __builtin_amdgcn_mfma_f32_16x16x32_bf16(a, b, acc[cs], 0, 0, 0); } }
    PG8_LAS float* part = (PG8_LAS float*)lds;
    PG8_LAS float* hid = part + 8 * 16 * 128;
    __syncthreads();
#pragma unroll
    for (int cs = 0; cs < 8; ++cs)
#pragma unroll
        for (int j = 0; j < 4; ++j) part[(wid * 16 + fq * 4 + j) * 128 + cs * 16 + fr] = acc[cs][j];
    __syncthreads();
    const int row = tid >> 5, c4 = (tid & 31) * 4;
    { const float* cb = WSP(float, WS_CB) + which * 128 + c4; float s[4] = {cb[0], cb[1], cb[2], cb[3]};
#pragma unroll
        for (int w = 0; w < 8; ++w) { const f32x4 v = *(PG8_LAS const f32x4*)(part + (w * 16 + row) * 128 + c4); s[0] += v[0]; s[1] += v[1]; s[2] += v[2]; s[3] += v[3]; }
#pragma unroll
        for (int j = 0; j < 4; ++j) hid[row * 128 + c4 + j] = gelu_tanh_f(s[j]); }
    __syncthreads();
    const float* w2 = which ? c.w_cv2 : c.w_ck2; float o4[4] = {0.f, 0.f, 0.f, 0.f};
#pragma unroll 16
    for (int k = 0; k < 128; ++k) { const float hv = hid[row * 128 + k]; const f32x4 wv = *(const f32x4*)(w2 + (size_t)k * 128 + c4); o4[0] += hv * wv[0]; o4[1] += hv * wv[1]; o4[2] += hv * wv[2]; o4[3] += hv * wv[3]; }
    const bool real = n0 + row < NC; u32x2 w; w.x = real ? pk2(o4[0], o4[1]) : 0u; w.y = real ? pk2(o4[2], o4[3]) : 0u;
    *(u32x2*)(WSP(bf16_t, which ? WS_VCC : WS_KCC) + ((size_t)g * NCP + n0 + row) * 128 + c4) = w;
    __syncthreads();
}

__device__ __forceinline__ void nsa_unit(const Ctx& c, PG8_LAS unsigned char* lds, int u, at::BgConvGU& bg) {
    using namespace at;
    const int tid = threadIdx.x, wid = __builtin_amdgcn_readfirstlane(tid >> 6), lane = tid & 63, r32 = lane & 31, hi = lane >> 5;
    const int g = u & 3, qt = u >> 2, P0 = qt * 64, ql = wid * 8 + (r32 >> 2), pq = P0 + ql, head = g * 4 + (r32 & 3), qmin = P0 + wid * 8;
    PG8_LAS unsigned* imp = (PG8_LAS unsigned*)(lds + OFF_IMP); PG8_LAS unsigned* sel = (PG8_LAS unsigned*)(lds + OFF_SEL);
    for (int i = tid; i < 64 * IMP_LD; i += 512) imp[i] = 0u;
    const float* gt = WSP(float, WS_GNSA) + (size_t)pq * 48 + head * 3;
    bf16_t* yrow0 = WSP(bf16_t, WS_YC) + 512 + (size_t)g * 512;
    auto rowptr = [&](int orow) { return yrow0 + (size_t)(qmin + (orow >> 2)) * KAB + (orow & 3) * 128; };
    bf16x8 qr[8]; f32x16 o[4];
#define ZERO_O() do { _Pragma("unroll") for (int d = 0; d < 4; ++d) _Pragma("unroll") for (int r = 0; r < 16; ++r) o[d][r] = 0.f; } while (0)
    { const bf16_t* Q = WSP(bf16_t, WS_QBR) + (size_t)pq * 2048 + head * 128;
#pragma unroll
      for (int d0 = 0; d0 < 8; ++d0) qr[d0] = *(const bf16x8*)(Q + d0 * 16 + hi * 8); }
    {
        KV kv{WSP(bf16_t, WS_KCC) + (size_t)g * NCP * 128, WSP(bf16_t, WS_VCC) + (size_t)g * NCP * 128, 128, 128};
        const int limm1 = (pq - 31) >> 4;
        PolCmp pol{(qmin - 31) >> 4, (qmin + 7 - 31) >> 4};
        const int ntc = (((P0 + 63 - 31) >> 4) >> 6) + 1;
        float m_reg = -1e30f, l_reg = 0.f; ZERO_O();
        BgNone nobg; flash_loop<1>(pol, lds, kv, 0, ntc, qr, limm1 - 4 * hi, o, m_reg, l_reg, 0.f, nullptr, nobg);
        const float inv_l = l_reg > 0.f ? 1.0f / l_reg : 0.f;
        flash_loop<2>(pol, lds, kv, 0, ntc, qr, limm1 - 4 * hi, o, m_reg, l_reg, inv_l, imp + ql * IMP_LD, nobg);
        store_o<false>(lds, o, gt[0], rowptr);
    }
    __syncthreads();
    {
        int l2 = threadIdx.x; asm volatile("" : "+v"(l2)); l2 &= 63;
        const int m0 = l2, m1 = 64 + l2; const unsigned long long below = (1ull << l2) - 1ull;
        for (int i = 0; i < 4; ++i) {
            const int qa = wid * 8 + i, qb = qa + 4, posa = P0 + qa, posb = P0 + qb, cura = posa >> 6, curb = posb >> 6;
            PG8_LAS const unsigned* rowa = imp + qa * IMP_LD; PG8_LAS const unsigned* rowb = imp + qb * IMP_LD;
            const unsigned k0a = (m0 * 64 <= posa) ? (1u + rowa[m0] + (((m0 == 0) || (m0 == cura) || (m0 == cura - 1)) ? 0x80000000u : 0u)) : 0u;
            const unsigned k1a = (m1 * 64 <= posa) ? (1u + rowa[m1] + (((m1 == cura) || (m1 == cura - 1)) ? 0x80000000u : 0u)) : 0u;
            const unsigned k0b = (m0 * 64 <= posb) ? (1u + rowb[m0] + (((m0 == 0) || (m0 == curb) || (m0 == curb - 1)) ? 0x80000000u : 0u)) : 0u;
            const unsigned k1b = (m1 * 64 <= posb) ? (1u + rowb[m1] + (((m1 == curb) || (m1 == curb - 1)) ? 0x80000000u : 0u)) : 0u;
            unsigned Ta = 0u, Tb = 0u;
            for (int bbit = 31; bbit >= 0; --bbit) { const unsigned ca = Ta | (1u << bbit), cb = Tb | (1u << bbit);
                const int na = __popcll(__ballot(k0a >= ca)) + __popcll(__ballot(k1a >= ca)), nbb = __popcll(__ballot(k0b >= cb)) + __popcll(__ballot(k1b >= cb));
                Ta = na >= 16 ? ca : Ta; Tb = nbb >= 16 ? cb : Tb; }
#define TOPK_TAIL(k0, k1, T, q) do { \
            const unsigned long long g0m = __ballot(k0 > T), g1m = __ballot(k1 > T), e0m = __ballot(k0 == T), e1m = __ballot(k1 == T); \
            const int need = 16 - (__popcll(g0m) + __popcll(g1m));                         \
            const bool s0 = (k0 > T) || ((k0 == T) && (__popcll(e0m & below) < need)); \
            const bool s1 = (k1 > T) || ((k1 == T) && (__popcll(e0m) + __popcll(e1m & below) < need)); \
            const unsigned long long b0 = __ballot(s0), b1 = __ballot(s1); \
            if (l2 == 0) { sel[(q) * 4 + 0] = (unsigned)b0; sel[(q) * 4 + 1] = (unsigned)(b0 >> 32); sel[(q) * 4 + 2] = (unsigned)b1; sel[(q) * 4 + 3] = (unsigned)(b1 >> 32); } } while (0)
            TOPK_TAIL(k0a, k1a, Ta, qa); TOPK_TAIL(k0b, k1b, Tb, qb);
#undef TOPK_TAIL
        }
    }
    __syncthreads();
    { const bf16_t* Q = WSP(bf16_t, WS_QBT) + (size_t)pq * 2048 + head * 128;
#pragma unroll
      for (int d0 = 0; d0 < 8; ++d0) qr[d0] = *(const bf16x8*)(Q + d0 * 16 + hi * 8); }
    {
        KV kv{WSP(bf16_t, WS_KS) + g * 128, WSP(bf16_t, WS_VS) + g * 128, 512, 512};
        PolSel pol{sel + ql * 4, qt};
        float m_reg = -1e30f, l_reg = 0.f; ZERO_O();
        flash_loop<0>(pol, lds, kv, 0, qt + 1, qr, pq - 4 * hi, o, m_reg, l_reg, 0.f, nullptr, bg);
        store_o<true>(lds, o, gt[1] / l_reg, rowptr);
    }
    {
        KV kv{WSP(bf16_t, WS_KW) + g * 128, WSP(bf16_t, WS_VW) + g * 128, 512, 512};
        PolWin pol{qmin, qmin + 7, 512};
        const int j_lo = (P0 - 511 > 0 ? P0 - 511 : 0) / 64;
        float m_reg = -1e30f, l_reg = 0.f; ZERO_O();
        flash_loop<0>(pol, lds, kv, j_lo, qt + 1 - j_lo, qr, pq - 4 * hi, o, m_reg, l_reg, 0.f, nullptr, bg);
        store_o<true>(lds, o, gt[2] / l_reg, rowptr);
    }
#undef ZERO_O
    __syncthreads();
}

constexpr int LDS_CTL_OFF = 136 * 1024;
constexpr int LDS_BYTES = LDS_CTL_OFF + 64;
constexpr int NPHASE = 13;
struct Args { Ctx c; int ph_lo, ph_hi, li, pad; };

__device__ __forceinline__ int ftid_() { int t = threadIdx.x; asm volatile("" : "+v"(t)); return t; }
__global__ void __launch_bounds__(512, 2) mega(Args a) {
    extern __shared__ __attribute__((aligned(16))) unsigned char lds_raw[];
    PG8_LAS unsigned char* lds = (PG8_LAS unsigned char*)lds_raw;
    const Ctx& c = a.c;
    const int tid = threadIdx.x, bid = blockIdx.x, nb = gridDim.x;
    if (tid < 16) ((PG8_LAS unsigned*)(lds + LDS_CTL_OFF))[tid] = 0u;
    __syncthreads();
    XcdBarrier bar = xcd_barrier_post((unsigned*)(c.ws + WS_CTL) + a.li * XCD_BAR_WORDS, (volatile LAS unsigned*)(lds + LDS_CTL_OFF));
    const int lo = a.ph_lo, hi = a.ph_hi;
#ifndef PHMASK
#define PHMASK 0xFFFF
#endif
#define IN(k) (((PHMASK >> (k)) & 1) && lo <= (k) && (k) < hi)
#define SEAM(k) do { if (IN(k) && IN((k) + 1)) xcd_barrier(bar); } while (0)
    unsigned char* ws = c.ws;
    float* tile = (float*)lds_raw;
    if (IN(0)) {
        const int gw = bid * 8 + (tid >> 6), nw = nb * 8;
        if (nb != 256) convert_wt<true>(c.w_gu, DM, NGU, WSP(bf16_t, WS_WGUT), LD8 / 2, 0, NGU, MapGU(), lds, gw, nw);
        if (nb != 256) convert_wt<true>(c.w_down, DFF / 2, DM, WSP(bf16_t, WS_WDT), LDA8 / 2, 0, DM, MapId(), lds, gw, nw);
        if (nb != 256) convert_wt<true>(c.w_down + (size_t)(DFF / 2) * DM, DFF / 2, DM, WSP(bf16_t, WS_WDT), LDA8 / 2, DFF / 4, DM, MapId(), lds, gw, nw);
        if (nb != 256) convert_wt<false>(c.w_out, DM, DM, WSP(bf16_t, WS_WOT), LDK, 0, DM, MapId(), lds, gw, nw);
        if (nb != 256) convert_wt<true>(c.w_ple_gate, DM, DM, WSP(bf16_t, WS_WGT), LD8 / 2, 0, DM, MapId(), lds, gw, nw);
        if (nb != 256) { convert_wt<false>(c.w_a, 512, DM, WSP(bf16_t, WS_WABT), KAB, 0, DM, MapId(), lds, gw, nw);
                         convert_wt<false>(c.w_b, 2048, DM, WSP(bf16_t, WS_WABT), KAB, 512, DM, MapId(), lds, gw, nw); }
        convert_wt<false>(c.w_ple, PLE, DM, WSP(bf16_t, WS_WPT), PLE, 0, DM, MapId(), lds, gw, nw);
        convert_wt<false>(c.w_ck1, 4096, 128, WSP(bf16_t, WS_WCK1T), 4096, 0, 128, MapId(), lds, gw, nw);
        convert_wt<false>(c.w_cv1, 4096, 128, WSP(bf16_t, WS_WCV1T), 4096, 0, 128, MapId(), lds, gw, nw);
        convert_wt<false>(c.w_in, DM, IN_W, WSP(bf16_t, WS_W1T), LDK, 0, N1P, MapIn(), lds, gw, nw);
        convert_wt<true>(c.w_in, DM, IN_W, WSP(bf16_t, WS_W1G8), LD8 / 2, 0, 8192, MapGM(), lds, gw, nw);
        rmsnorm_rows(c.x, c.g_mix_pre, WSP(bf16_t, WS_HB), WSP(unsigned char, WS_H8), bid, nb);
        for (size_t i = (size_t)bid * 512 + tid; i < (size_t)S * PLE / 4; i += (size_t)nb * 512) { const f32x4 v = *(const f32x4*)(c.p + i * 4); u32x2 w; w.x = pk2(v[0], v[1]); w.y = pk2(v[2], v[3]); *(u32x2*)(WSP(bf16_t, WS_PB) + i * 4) = w; }
        for (int i = bid * 512 + tid; i < S * 64; i += nb * 512) { const int pos = i >> 6, f = i & 63; double iv = 1.0; for (int q = 0; q < f; ++q) iv *= 0.8659643233600653;
            const float ang = (float)pos * (float)iv; double rev = (double)ang * 0.15915494309189535; rev -= rint(rev);
            WSP(float, WS_ROPEC)[i] = __builtin_amdgcn_cosf((float)rev); WSP(float, WS_ROPES)[i] = __builtin_amdgcn_sinf((float)rev); }
        for (int sl = bid; sl < 256; sl += nb) if (tid < 256) { const int which = tid >> 7, col = tid & 127; const float* pe = which ? c.pe_cv : c.pe_ck; const float* w1 = which ? c.w_cv1 : c.w_ck1; float s_ = 0.f;
#pragma unroll
            for (int k = sl * 16; k < sl * 16 + 16; ++k) s_ += pe[k] * w1[(size_t)k * 128 + col];
            WSP(float, WS_CBP)[sl * 256 + tid] = s_; }
        __syncthreads();
    }
    SEAM(0);
    if (IN(1)) {
        { pg8::Gemm g{WSP(bf16_t, WS_HB), WSP(bf16_t, WS_W1T), S, N1P, DM, LDK, LDK}; pg8::StaticOrder so; so.init(S, N1P, nb, bid); pg8::gemm_phase(lds, g, so, EpiIn{ws}); }
        { pg8::Gemm g{WSP(bf16_t, WS_H8), WSP(bf16_t, WS_W1G8), S, 8192, DM / 2, LD8 / 2, LD8 / 2}; pg8::StaticOrder so; so.init(S, 8192, nb, bid); pg8::gemm_phase<EpiGate8, pg8::StaticOrder, true>(lds, g, so, EpiGate8{WSP(bf16_t, WS_GMIX)}); }
        if (bid == nb - 1 && tid < 256) { float s_ = 0.f;
#pragma unroll 16
            for (int sl = 0; sl < 256; ++sl) s_ += WSP(float, WS_CBP)[sl * 256 + tid];
            WSP(float, WS_CB)[tid] = s_; }
        if (nb == 256 && bid >= 224) { __syncthreads(); convert_wt<true>(c.w_ple_gate, DM, DM, WSP(bf16_t, WS_WGT), LD8 / 2, 0, DM, MapId(), lds, (bid - 224) * 8 + (tid >> 6), 32 * 8); __syncthreads(); }
    }
    SEAM(1);
    if (IN(2)) {
        for (int u = bid; u < 384 + 256; u += nb) { if (u < 384) dilated_unit(c, lds, u); else compress_unit(c, lds, u - 384); }
        if (nb == 256 && bid >= 128) { __syncthreads(); convert_wt<false>(c.w_out, DM, DM, WSP(bf16_t, WS_WOT), LDK, 0, DM, MapId(), lds, (bid - 128) * 8 + (tid >> 6), 128 * 8); __syncthreads(); }
    }
    SEAM(2);
    if (IN(3)) {
        dilated_combine(c, bid, nb);
        at::BgConvGU bgc; { const int w_ = __builtin_amdgcn_readfirstlane(ftid_() >> 6); bgc.init(c.w_gu, c.ws + WS_WGUT, c.w_down, c.ws + WS_WDT, c.w_a, c.w_b, c.ws + WS_WABT, lds + at::OFF_IMP + w_ * 4096, bid * 8 + w_, nb == 256); }
        for (int i = bid; i < 256; i += nb) { nsa_unit(c, lds, 256 + i, bgc); nsa_unit(c, lds, 255 - i, bgc); }
        while (bgc.want()) { bgc.issue(ftid_() & 63); asm volatile("s_waitcnt vmcnt(0)" ::: "memory"); bgc.commit(ftid_() & 63); }
    }
    SEAM(3);
    if (IN(4)) {
        { pg8::Gemm g{WSP(bf16_t, WS_YC), WSP(bf16_t, WS_WABT), S, DM, 512, KAB, KAB}; pg8::StaticOrder so; so.init(S, DM, nb, bid); pg8::gemm_phase(lds, g, so, EpiGateA{WSP(bf16_t, WS_GMIX), WSP(bf16_t, WS_MG)}); }
        { pg8::Gemm g{WSP(bf16_t, WS_YC) + 512, WSP(bf16_t, WS_WABT) + 512, S, DM, 2048, KAB, KAB}; pg8::StaticOrder so; so.init(S, DM, nb, bid); pg8::gemm_phase(lds, g, so, EpiGateB{WSP(bf16_t, WS_GMIX), WSP(bf16_t, WS_MG)}); }
    }
    SEAM(4);
    if (IN(5)) { pg8::Gemm g{WSP(bf16_t, WS_MG), WSP(bf16_t, WS_WOT), S, DM, DM, LDK, LDK}; pg8::StaticOrder so; so.init(S, DM, nb, bid); pg8::gemm_phase(lds, g, so, EpiSS{WSP(bf16_t, WS_MX), WSP(float, WS_PART), nullptr, 1.0f, nullptr}); }
    SEAM(5);
    if (IN(6)) {
        { int kp = PLE; asm volatile("" : "+s"(kp));
          pg8::Gemm g{WSP(bf16_t, WS_PB), WSP(bf16_t, WS_WPT), S, DM, kp, PLE, PLE}; pg8::StaticOrder so; so.init(S, DM, nb, bid); pg8::gemm_phase(lds, g, so, EpiPlain{WSP(bf16_t, WS_MG)}); }
        resnorm_rows<false, true, true, true>(c.x, WSP(bf16_t, WS_MX), WSP(float, WS_PART), c.g_mix_post, c.g_ffn_pre, WSP(bf16_t, WS_XR), WSP(bf16_t, WS_HB), bid, nb, WSP(float, WS_R2));
    }
    SEAM(6);
    if (IN(7)) { pg8::Gemm g{WSP(bf16_t, WS_HB), WSP(bf16_t, WS_WGUT), S, NGU, DM / 2, LD8 / 2, LD8 / 2}; pg8::StaticOrder so; so.init(S, NGU, nb, bid); pg8::gemm_phase<EpiSwiglu, pg8::StaticOrder, true>(lds, g, so, EpiSwiglu{WSP(bf16_t, WS_ACT), WSP(float, WS_R2)}); }
    if (IN(7) && nb == 256 && bid >= 192) { __syncthreads(); convert_wt<true>(c.w_down + (size_t)(DFF / 2) * DM, DFF / 2, DM, WSP(bf16_t, WS_WDT), LDA8 / 2, DFF / 4, DM, MapId(), lds, (bid - 192) * 8 + (tid >> 6), 64 * 8); __syncthreads(); }
    SEAM(7);
    if (IN(8)) { pg8::Gemm g{WSP(bf16_t, WS_ACT), WSP(bf16_t, WS_WDT), S, DM, DFF / 2, LDA8 / 2, LDA8 / 2}; pg8::StaticOrder so; so.init(S, DM, nb, bid); pg8::gemm_phase<EpiSS, pg8::StaticOrder, true>(lds, g, so, EpiSS{WSP(bf16_t, WS_MX), WSP(float, WS_PART), nullptr, 1.0f / W8SCALE, nullptr}); }
    SEAM(8);
    if (IN(9)) resnorm_rows<true, true, true, true>(WSP(bf16_t, WS_XR), WSP(bf16_t, WS_MX), WSP(float, WS_PART), c.g_ffn_post, c.g_ple_pre, WSP(bf16_t, WS_XR), WSP(bf16_t, WS_HB), bid, nb, WSP(float, WS_R2));
    SEAM(9);
    if (IN(10)) { pg8::Gemm g{WSP(bf16_t, WS_HB), WSP(bf16_t, WS_WGT), S, DM, DM / 2, LD8 / 2, LD8 / 2}; pg8::StaticOrder so; so.init(S, DM, nb, bid); pg8::gemm_phase<EpiSS, pg8::StaticOrder, true>(lds, g, so, EpiSS{WSP(bf16_t, WS_MX), WSP(float, WS_PART), WSP(bf16_t, WS_MG), 1.0f / W8SCALE, WSP(float, WS_R2)}); }
    SEAM(10);
    if (IN(11)) resnorm_rows<true, false, false>(WSP(bf16_t, WS_XR), WSP(bf16_t, WS_MX), WSP(float, WS_PART), c.g_ple_post, nullptr, c.out, nullptr, bid, nb);
#undef IN
#undef SEAM
}
}

extern "C" void kernel_launch(void* const* d_in, const int* in_sizes, int n_in, void* d_out, int out_size, void* d_ws, size_t ws_size, hipStream_t stream) {
    using namespace hk;
    if (n_in != 22 || ws_size < WS_END) return;
    static int grid = 0;
    if (grid == 0) {
        int dev = 0, cus = 0, per_cu = 0;
        hipGetDevice(&dev); hipDeviceGetAttribute(&cus, hipDeviceAttributeMultiprocessorCount, dev);
        hipFuncSetAttribute((const void*)mega, hipFuncAttributeMaxDynamicSharedMemorySize, LDS_BYTES);
        hipOccupancyMaxActiveBlocksPerMultiprocessor(&per_cu, (const void*)mega, 512, LDS_BYTES);
        (void)hipGetLastError();
        grid = cus > 0 ? cus : 256;
    }
    Args a{};
    const float** f = (const float**)&a.c;
    for (int i = 0; i < 22; ++i) f[i] = (const float*)d_in[i];
    a.c.out = (float*)d_out; a.c.ws = (unsigned char*)d_ws;
    Ctx c = a.c;
    hipMemsetAsync((char*)d_ws + WS_CTL, 0, 65536, stream);
#ifdef PROBE_LO
    a.ph_lo = 0; a.ph_hi = PROBE_HI; a.li = 0;
    hipLaunchKernelGGL(mega, dim3(grid), dim3(512), LDS_BYTES, stream, a);
    a.ph_lo = PROBE_LO; a.ph_hi = NPHASE; a.li = 1;
    hipLaunchKernelGGL(mega, dim3(grid), dim3(512), LDS_BYTES, stream, a);
#else
    a.ph_lo = 0; a.ph_hi = NPHASE; a.li = 0;
    hipLaunchKernelGGL(mega, dim3(grid), dim3(512), LDS_BYTES, stream, a);
#endif
}
```
